# Optimizing an MI355X kernel written in HIP

```python
import math
import jax, jax.numpy as jnp
from jax import lax
import numpy as np

D_MODEL = 1024
BATCH = 8
SEQ = 4096
DEPTH = 1

CHUNK = 64
CONV_DIM = 512
CONV_WIDTH = 31
SB_HEADS = 8
SB_HEAD_DIM = 64
SB_DIM = SB_HEADS * SB_HEAD_DIM
Q_BLOCK = 128
N_BRANCH = 2
PEER_HEADS = 8
PEER_KEY_DIM = 256
PEER_HALF = PEER_KEY_DIM // 2
N_KEYS = 128
N_EXPERTS = N_KEYS * N_KEYS
PEER_TOPK = 16
TOKEN_BLOCK = 128
LN_EPS = 1e-5
DEEPNORM_ALPHA = (2.0 * DEPTH) ** 0.25
DEEPNORM_BETA = (8.0 * DEPTH) ** -0.25

COL_CONV = 0
COL_Q = COL_CONV + 2 * CONV_DIM
COL_K = COL_Q + SB_DIM
COL_V = COL_K + SB_DIM
COL_GATE = COL_V + SB_DIM
IN_COLS = COL_GATE + N_BRANCH * D_MODEL

kernel_name = "hybrid_conv_stickbreak_peer_deepnorm"


def layer_norm(x, g, b):
    xf = x.astype(jnp.float32)
    mu = jnp.mean(xf, axis=-1, keepdims=True)
    var = jnp.mean(jnp.square(xf - mu), axis=-1, keepdims=True)
    y = (xf - mu) * lax.rsqrt(var + LN_EPS) * g.astype(jnp.float32) + b.astype(jnp.float32)
    return y.astype(x.dtype)


def conformer_conv(h_glu, w_dw, b_dw, ln_g, ln_b, w_pw2, b_pw2):
    a, gate = jnp.split(h_glu, 2, axis=-1)
    h = a * jax.nn.sigmoid(gate)
    h = lax.conv_general_dilated(
        h, w_dw[:, None, :], window_strides=(1,),
        padding=[(CONV_WIDTH - 1, 0)],
        dimension_numbers=('NWC', 'WIO', 'NWC'),
        feature_group_count=CONV_DIM) + b_dw
    h = layer_norm(h, ln_g, ln_b)
    h = jax.nn.silu(h)
    return h @ w_pw2 + b_pw2


def stick_breaking_attention(q, k, v):
    B, H, S, dh = q.shape
    nb = S // Q_BLOCK
    qb = q.reshape(B, H, nb, Q_BLOCK, dh).transpose(2, 0, 1, 3, 4)
    kf = k.astype(jnp.float32)
    vf = v.astype(jnp.float32)
    key_pos = jnp.arange(S)
    scale = 1.0 / math.sqrt(dh)

    def block(args):
        qi, i = args
        z = jnp.einsum('bhqd,bhkd->bhqk', qi.astype(jnp.float32), kf) * scale
        q_pos = i * Q_BLOCK + jnp.arange(Q_BLOCK)
        mask = key_pos[None, :] < q_pos[:, None]
        log_beta = jax.nn.log_sigmoid(z)
        log_one_minus = jnp.where(mask, jax.nn.log_sigmoid(-z), 0.0)
        suffix = lax.cumsum(log_one_minus, axis=3, reverse=True) - log_one_minus
        att = jnp.where(mask, jnp.exp(log_beta + suffix), 0.0)
        return jnp.einsum('bhqk,bhkd->bhqd', att, vf)

    out = lax.map(block, (qb, jnp.arange(nb)))
    out = out.transpose(1, 0, 3, 2, 4).reshape(B, S, H * dh)
    return out.astype(q.dtype)


def peer(x, w_q, keys_1, keys_2, expert_u, expert_v):
    B, S, D = x.shape
    xt = x.reshape(-1, TOKEN_BLOCK, D)
    k1 = keys_1.astype(jnp.float32)
    k2 = keys_2.astype(jnp.float32)

    def block(xb):
        q = (xb @ w_q).astype(jnp.float32).reshape(TOKEN_BLOCK, PEER_HEADS, 2, PEER_HALF)
        s1 = jnp.einsum('thd,hkd->thk', q[:, :, 0], k1)
        s2 = jnp.einsum('thd,hkd->thk', q[:, :, 1], k2)
        v1, i1 = lax.top_k(s1, PEER_TOPK)
        v2, i2 = lax.top_k(s2, PEER_TOPK)
        cand_s = (v1[..., :, None] + v2[..., None, :]).reshape(TOKEN_BLOCK, PEER_HEADS, PEER_TOPK * PEER_TOPK)
        cand_i = (i1[..., :, None] * N_KEYS + i2[..., None, :]).reshape(TOKEN_BLOCK, PEER_HEADS, PEER_TOPK * PEER_TOPK)
        top_s, pos = lax.top_k(cand_s, PEER_TOPK)
        idx = jnp.take_along_axis(cand_i, pos, axis=-1)
        gate = jax.nn.softmax(top_s, axis=-1)
        u = expert_u[idx]
        vv = expert_v[idx]
        act = jax.nn.gelu(jnp.einsum('td,thkd->thk', xb, u).astype(jnp.float32), approximate=False)
        return jnp.einsum('thk,thkd->td', (gate * act).astype(xb.dtype), vv)

    out = lax.map(block, xt)
    return out.reshape(B, S, D)


def setup_inputs(seed: int = 0) -> dict:
    key = jax.random.key(seed)
    ks = jax.random.split(key, 24)
    L, D = DEPTH, D_MODEL
    f32 = jnp.float32
    nrm = lambda k, shape, s: jax.random.normal(k, shape, f32) * s

    x = jax.random.normal(ks[0], (BATCH, SEQ, D), f32)
    w_in = nrm(ks[1], (L, D, IN_COLS), D ** -0.5)
    col_scale = jnp.ones((IN_COLS,), f32).at[COL_V:COL_GATE].set(DEEPNORM_BETA)
    w_in = w_in * col_scale
    b_in = nrm(ks[2], (L, IN_COLS), 0.02)
    conv_w_dw = nrm(ks[3], (L, CONV_WIDTH, CONV_DIM), CONV_WIDTH ** -0.5)
    conv_b_dw = nrm(ks[4], (L, CONV_DIM), 0.02)
    conv_ln_g = 1.0 + nrm(ks[5], (L, CONV_DIM), 0.02)
    conv_ln_b = nrm(ks[6], (L, CONV_DIM), 0.02)
    conv_w_pw2 = nrm(ks[7], (L, CONV_DIM, D), DEEPNORM_BETA * CONV_DIM ** -0.5)
    conv_b_pw2 = nrm(ks[8], (L, D), 0.02)
    sb_w_o = nrm(ks[9], (L, SB_DIM, D), DEEPNORM_BETA * SB_DIM ** -0.5)
    w_out = nrm(ks[10], (L, D, D), DEEPNORM_BETA * D ** -0.5)
    b_out = nrm(ks[11], (L, D), 0.02)
    ln1_g = 1.0 + nrm(ks[12], (L, D), 0.02)
    ln1_b = nrm(ks[13], (L, D), 0.02)
    peer_w_q = nrm(ks[14], (L, D, PEER_HEADS * PEER_KEY_DIM), D ** -0.5)
    peer_keys_1 = nrm(ks[15], (L, PEER_HEADS, N_KEYS, PEER_HALF), PEER_HALF ** -0.5)
    peer_keys_2 = nrm(ks[16], (L, PEER_HEADS, N_KEYS, PEER_HALF), PEER_HALF ** -0.5)
    peer_u = nrm(ks[17], (L, N_EXPERTS, D), D ** -0.5)
    peer_v = nrm(ks[18], (L, N_EXPERTS, D), DEEPNORM_BETA)
    ln2_g = 1.0 + nrm(ks[19], (L, D), 0.02)
    ln2_b = nrm(ks[20], (L, D), 0.02)
    return {"x": x, "w_in": w_in, "b_in": b_in,
            "conv_w_dw": conv_w_dw, "conv_b_dw": conv_b_dw,
            "conv_ln_g": conv_ln_g, "conv_ln_b": conv_ln_b,
            "conv_w_pw2": conv_w_pw2, "conv_b_pw2": conv_b_pw2,
            "sb_w_o": sb_w_o, "w_out": w_out, "b_out": b_out,
            "ln1_g": ln1_g, "ln1_b": ln1_b,
            "peer_w_q": peer_w_q, "peer_keys_1": peer_keys_1, "peer_keys_2": peer_keys_2,
            "peer_u": peer_u, "peer_v": peer_v,
            "ln2_g": ln2_g, "ln2_b": ln2_b}


def reference(x, w_in, b_in, conv_w_dw, conv_b_dw, conv_ln_g, conv_ln_b,
              conv_w_pw2, conv_b_pw2, sb_w_o, w_out, b_out, ln1_g, ln1_b,
              peer_w_q, peer_keys_1, peer_keys_2, peer_u, peer_v, ln2_g, ln2_b):
    B, S, D = x.shape
    for l in range(DEPTH):
        h = x @ w_in[l] + b_in[l]
        h_conv = h[..., COL_CONV:COL_Q]
        q = h[..., COL_Q:COL_K].reshape(B, S, SB_HEADS, SB_HEAD_DIM).transpose(0, 2, 1, 3)
        k = h[..., COL_K:COL_V].reshape(B, S, SB_HEADS, SB_HEAD_DIM).transpose(0, 2, 1, 3)
        v = h[..., COL_V:COL_GATE].reshape(B, S, SB_HEADS, SB_HEAD_DIM).transpose(0, 2, 1, 3)
        g_conv = jax.nn.sigmoid(h[..., COL_GATE:COL_GATE + D])
        g_sb = jax.nn.sigmoid(h[..., COL_GATE + D:IN_COLS])

        y_conv = conformer_conv(h_conv, conv_w_dw[l], conv_b_dw[l], conv_ln_g[l], conv_ln_b[l],
                                conv_w_pw2[l], conv_b_pw2[l])
        y_sb = stick_breaking_attention(q, k, v) @ sb_w_o[l]
        mix = (g_conv * y_conv + g_sb * y_sb) @ w_out[l] + b_out[l]
        x = layer_norm(DEEPNORM_ALPHA * x + mix, ln1_g[l], ln1_b[l])

        y_peer = peer(x, peer_w_q[l], peer_keys_1[l], peer_keys_2[l], peer_u[l], peer_v[l])
        x = layer_norm(DEEPNORM_ALPHA * x + y_peer, ln2_g[l], ln2_b[l])
    return x
```

```cpp
#include <hip/hip_runtime.h>
#include <hip/hip_bf16.h>
#include <cstdio>
#include <cstdint>
#include <cmath>

#ifndef MK_N_LAUNCHES
#define MK_N_LAUNCHES 1
#endif

namespace pg8 {
#define PG8_LAS __attribute__((address_space(3)))
typedef unsigned short bf16_t;
typedef short bf16x8 __attribute__((ext_vector_type(8)));
typedef float f32x4 __attribute__((ext_vector_type(4)));
typedef unsigned u32x4 __attribute__((ext_vector_type(4)));
constexpr int BM = 256, BK = 64, HALF = 128, HTB = HALF * BK * 2, STAGE_BYTES = 8 * HTB, NXCD = 8, WGM = 8;

__host__ __device__ __forceinline__ int lds_byte(int r, int c) { const int st = (r >> 4) * 2 + (c >> 5), rr = r & 15, cc = c & 31, ob = rr * 64 + cc * 2; return st * 1024 + (ob ^ (((ob >> 9) & 1) << 5)); }
__host__ __device__ __forceinline__ void stage_rc(int b, int& R, int& C) { const int st = b / 1024, sb = b % 1024, swz = sb ^ (((sb >> 9) & 1) << 5); R = (st >> 1) * 16 + swz / 64; C = (st & 1) * 32 + (swz % 64) / 2; }
__host__ __device__ __forceinline__ int perm32(int rho) { const int n = rho >> 4, i = rho & 15; return 8 * (i >> 2) + 4 * n + (i & 3); }

struct Unit { int pm, pn; };
struct Gemm { const bf16_t* A; const bf16_t* Bt; int M, N, K, lda, ldb; };

struct StaticOrder {
    int nM, nN, nwg, G, c;
    __host__ __device__ void init(int M, int N, int G_, int c_) { nM = M / BM; nN = N / BM; nwg = nM * nN; G = G_; c = c_; }
    __host__ __device__ bool next(int i, Unit& u) const {
        const long L = (long)i * G + c; if (L >= nwg) return false;
        int wgid = (int)L; { const int q = nwg / NXCD, r = nwg % NXCD, xcd = wgid % NXCD, off = wgid / NXCD; wgid = (xcd < r ? xcd * (q + 1) : r * (q + 1) + (xcd - r) * q) + off; }
        const int nig = WGM * nN, gid = wgid / nig, fm = gid * WGM, gsz = (nM - fm) < WGM ? (nM - fm) : WGM;
        u.pm = fm + ((wgid % nig) % gsz); u.pn = (wgid % nig) / gsz; return true;
    }
    __device__ __forceinline__ void a_ready(const Unit&) const {}
    __device__ __forceinline__ void done(const Unit&) const {}
};

__device__ __forceinline__ unsigned cvt_pk_bf16(float lo, float hi) { typedef float f2_t __attribute__((ext_vector_type(2))); typedef __bf16 b2_t __attribute__((ext_vector_type(2))); f2_t v = {lo, hi}; b2_t b = __builtin_convertvector(v, b2_t); return __builtin_bit_cast(unsigned, b); }
__device__ __forceinline__ float sigmoid_f(float x) { return __builtin_amdgcn_rcpf(1.0f + __builtin_amdgcn_exp2f(-1.4426950408889634f * x)); }

struct EpiF32 {
    static constexpr bool PERM = false, AFTER_DRAIN = false;
    float* C; int ldc;
    __device__ __forceinline__ void operator()(const f32x4 (&acc)[2][2][4][2], const Unit& u, int wr, int wc, int fr, int fq) const {
        const int row0 = u.pm * BM + wr * 64 + fr, col0 = u.pn * BM + wc * 32 + 4 * fq;
#pragma unroll
        for (int ai = 0; ai < 2; ++ai)
#pragma unroll
            for (int m = 0; m < 4; ++m) { float* rowp = C + (size_t)(row0 + ai * HALF + m * 16) * ldc + col0;
#pragma unroll
                for (int bj = 0; bj < 2; ++bj)
#pragma unroll
                    for (int n = 0; n < 2; ++n) *(f32x4*)(rowp + bj * HALF + n * 16) = acc[ai][bj][m][n]; }
    }
};
struct EpiRes {
    static constexpr bool PERM = false, AFTER_DRAIN = false;
    float* C; const float* X; const float* bias; float alpha; int ldc;
    __device__ __forceinline__ void operator()(const f32x4 (&acc)[2][2][4][2], const Unit& u, int wr, int wc, int fr, int fq) const {
        const int row0 = u.pm * BM + wr * 64 + fr, col0 = u.pn * BM + wc * 32 + 4 * fq;
        f32x4 bv[2][2];
#pragma unroll
        for (int bj = 0; bj < 2; ++bj)
#pragma unroll
            for (int n = 0; n < 2; ++n) bv[bj][n] = *(const f32x4*)(bias + col0 + bj * HALF + n * 16);
#pragma unroll
        for (int ai = 0; ai < 2; ++ai)
#pragma unroll
            for (int m = 0; m < 4; ++m) { const size_t off = (size_t)(row0 + ai * HALF + m * 16) * ldc + col0;
#pragma unroll
                for (int bj = 0; bj < 2; ++bj)
#pragma unroll
                    for (int n = 0; n < 2; ++n) { const f32x4 xv = *(const f32x4*)(X + off + bj * HALF + n * 16);
                        *(f32x4*)(C + off + bj * HALF + n * 16) = acc[ai][bj][m][n] + bv[bj][n] + xv * alpha; } }
    }
};
struct EpiIn {
    static constexpr bool PERM = true, AFTER_DRAIN = false;
    const float* b_in; bf16_t* GLU; bf16_t* Q; bf16_t* Kb; bf16_t* G; float qscale;
    __device__ __forceinline__ void operator()(const f32x4 (&acc)[2][2][4][2], const Unit& u, int wr, int wc, int fr, int fq) const {
        const int row0 = u.pm * BM + wr * 64 + fr; const int cw = wc * 32 + 8 * fq;
        if (u.pn < 4) {
            const int oc = u.pn * 128 + cw;
            const f32x4 ba0 = *(const f32x4*)(b_in + oc), ba1 = *(const f32x4*)(b_in + oc + 4), bg0 = *(const f32x4*)(b_in + 512 + oc), bg1 = *(const f32x4*)(b_in + 512 + oc + 4);
#pragma unroll
            for (int ai = 0; ai < 2; ++ai)
#pragma unroll
                for (int m = 0; m < 4; ++m) { const size_t row = (size_t)(row0 + ai * HALF + m * 16);
                    const f32x4 a0 = acc[ai][0][m][0] + ba0, a1 = acc[ai][0][m][1] + ba1, g0 = acc[ai][1][m][0] + bg0, g1 = acc[ai][1][m][1] + bg1;
                    u32x4 w;
                    w.x = cvt_pk_bf16(a0[0] * sigmoid_f(g0[0]), a0[1] * sigmoid_f(g0[1])); w.y = cvt_pk_bf16(a0[2] * sigmoid_f(g0[2]), a0[3] * sigmoid_f(g0[3]));
                    w.z = cvt_pk_bf16(a1[0] * sigmoid_f(g1[0]), a1[1] * sigmoid_f(g1[1])); w.w = cvt_pk_bf16(a1[2] * sigmoid_f(g1[2]), a1[3] * sigmoid_f(g1[3]));
                    *(u32x4*)(GLU + row * 512 + oc) = w; }
        } else if (u.pn < 8) {
            const int which = (u.pn - 4) >> 1; bf16_t* base = which ? Kb : Q; const float sc = which ? 1.0f : qscale;
#pragma unroll
            for (int bj = 0; bj < 2; ++bj) { const int cwithin = ((u.pn - 4) & 1) * 256 + bj * HALF + cw; const int ocol = 1024 + which * 512 + cwithin;
                const f32x4 b0 = *(const f32x4*)(b_in + ocol), b1 = *(const f32x4*)(b_in + ocol + 4);
#pragma unroll
                for (int ai = 0; ai < 2; ++ai)
#pragma unroll
                    for (int m = 0; m < 4; ++m) { const size_t row = (size_t)(row0 + ai * HALF + m * 16);
                        const f32x4 v0 = (acc[ai][bj][m][0] + b0) * sc, v1 = (acc[ai][bj][m][1] + b1) * sc;
                        u32x4 w; w.x = cvt_pk_bf16(v0[0], v0[1]); w.y = cvt_pk_bf16(v0[2], v0[3]); w.z = cvt_pk_bf16(v1[0], v1[1]); w.w = cvt_pk_bf16(v1[2], v1[3]);
                        *(u32x4*)(base + row * 512 + cwithin) = w; } }
        } else {
#pragma unroll
            for (int bj = 0; bj < 2; ++bj) { const int gcol = (u.pn - 8) * 256 + bj * HALF + cw; const int ocol = 2560 + gcol;
                const f32x4 b0 = *(const f32x4*)(b_in + ocol), b1 = *(const f32x4*)(b_in + ocol + 4);
#pragma unroll
                for (int ai = 0; ai < 2; ++ai)
#pragma unroll
                    for (int m = 0; m < 4; ++m) { const size_t row = (size_t)(row0 + ai * HALF + m * 16);
                        const f32x4 v0 = acc[ai][bj][m][0] + b0, v1 = acc[ai][bj][m][1] + b1;
#ifdef DBG_NOSIG
                        u32x4 w; w.x = cvt_pk_bf16(v0[0], v0[1]); w.y = cvt_pk_bf16(v0[2], v0[3]); w.z = cvt_pk_bf16(v1[0], v1[1]); w.w = cvt_pk_bf16(v1[2], v1[3]);
#else
                        u32x4 w; w.x = cvt_pk_bf16(sigmoid_f(v0[0]), sigmoid_f(v0[1])); w.y = cvt_pk_bf16(sigmoid_f(v0[2]), sigmoid_f(v0[3]));
                        w.z = cvt_pk_bf16(sigmoid_f(v1[0]), sigmoid_f(v1[1])); w.w = cvt_pk_bf16(sigmoid_f(v1[2]), sigmoid_f(v1[3]));
#endif
                        *(u32x4*)(G + row * 2048 + gcol) = w; } }
        }
    }
};
struct EpiVT {
    static constexpr bool PERM = true, AFTER_DRAIN = false;
    const float* rbias; bf16_t* O; int ldc;
    __device__ __forceinline__ void operator()(const f32x4 (&acc)[2][2][4][2], const Unit& u, int wr, int wc, int fr, int fq) const {
        const int row0 = u.pm * BM + wr * 64 + fr; const int col0 = u.pn * BM + wc * 32 + 8 * fq;
#pragma unroll
        for (int ai = 0; ai < 2; ++ai)
#pragma unroll
            for (int m = 0; m < 4; ++m) { const int row = row0 + ai * HALF + m * 16; const float rb = rbias[row];
#pragma unroll
                for (int bj = 0; bj < 2; ++bj) { const f32x4 v0 = acc[ai][bj][m][0] + rb, v1 = acc[ai][bj][m][1] + rb;
                    u32x4 w; w.x = cvt_pk_bf16(v0[0], v0[1]); w.y = cvt_pk_bf16(v0[2], v0[3]); w.z = cvt_pk_bf16(v1[0], v1[1]); w.w = cvt_pk_bf16(v1[2], v1[3]);
                    *(u32x4*)(O + (size_t)row * ldc + col0 + bj * HALF) = w; } }
    }
};
struct EpiGate {
    static constexpr bool PERM = true, AFTER_DRAIN = false;
    const float* bias; const bf16_t* Gt; bf16_t* O; int gcol0, ocol0;
    __device__ __forceinline__ void operator()(const f32x4 (&acc)[2][2][4][2], const Unit& u, int wr, int wc, int fr, int fq) const {
        const int row0 = u.pm * BM + wr * 64 + fr; const int col0 = u.pn * BM + wc * 32 + 8 * fq;
#pragma unroll
        for (int bj = 0; bj < 2; ++bj) { const int c = col0 + bj * HALF;
            f32x4 b0 = (f32x4){0.f, 0.f, 0.f, 0.f}, b1 = b0; if (bias) { b0 = *(const f32x4*)(bias + c); b1 = *(const f32x4*)(bias + c + 4); }
#pragma unroll
            for (int ai = 0; ai < 2; ++ai)
#pragma unroll
                for (int m = 0; m < 4; ++m) { const size_t row = (size_t)(row0 + ai * HALF + m * 16);
                    const u32x4 gw = *(const u32x4*)(Gt + row * 2048 + gcol0 + c);
                    const f32x4 v0 = acc[ai][bj][m][0] + b0, v1 = acc[ai][bj][m][1] + b1;
                    u32x4 w;
                    w.x = cvt_pk_bf16(v0[0] * __uint_as_float(gw.x << 16), v0[1] * __uint_as_float(gw.x & 0xffff0000u));
                    w.y = cvt_pk_bf16(v0[2] * __uint_as_float(gw.y << 16), v0[3] * __uint_as_float(gw.y & 0xffff0000u));
                    w.z = cvt_pk_bf16(v1[0] * __uint_as_float(gw.z << 16), v1[1] * __uint_as_float(gw.z & 0xffff0000u));
                    w.w = cvt_pk_bf16(v1[2] * __uint_as_float(gw.w << 16), v1[3] * __uint_as_float(gw.w & 0xffff0000u));
                    *(u32x4*)(O + row * 2048 + ocol0 + c) = w; } }
    }
};

template <class Epi, class Sched, bool ALIGN_EPI = false, bool SP2 = false>
__device__ __forceinline__ void gemm_phase(PG8_LAS unsigned char* lds, const Gemm g, const Sched& S, const Epi& E) {
    const int tid = threadIdx.x, wid = __builtin_amdgcn_readfirstlane(tid >> 6), lane = tid & 63, wr = wid >> 2, wc = wid & 3, fr = lane & 15, fq = lane >> 4;
    const int K = g.K, nt = K / BK;
    unsigned voffA[2], voffB[2];
#pragma unroll
    for (int i = 0; i < 2; ++i) { int R, C; stage_rc(tid * 16 + i * 8192, R, C); const int Rb = Epi::PERM ? ((R & ~31) + perm32(R & 31)) : R;
        voffA[i] = (unsigned)(R * g.lda + C) * 2u; voffB[i] = (unsigned)(Rb * g.ldb + C) * 2u; }
    const size_t kstep = (size_t)(BK * 2);
    const size_t hstepA = (size_t)HALF * g.lda * 2, hstepB = (size_t)HALF * g.ldb * 2;
    const size_t tstepA = 2 * hstepA, tstepB = 2 * hstepB;
    const unsigned ldsw = (unsigned)wid * 1024u;
    const int aoff = lds_byte(wr * 64 + fr, fq * 8), boff = lds_byte(wc * 32 + fr, fq * 8);
#define PG8_SA(b, h) (((b) * 2 + (h)) * HTB)
#define PG8_SB(b, h) ((4 + (b) * 2 + (h)) * HTB)
#define PG8_STAGE(bufoff, gbase, voff) do { _Pragma("unroll") for (int _i = 0; _i < 2; ++_i) \
        __builtin_amdgcn_global_load_lds((const unsigned*)((const char*)(gbase) + (voff)[_i]), (PG8_LAS unsigned*)(lds + (bufoff) + ldsw + _i * 8192), 16, 0, 0); } while (0)
#define PG8_LDA(dst, b, h) do { _Pragma("unroll") for (int m = 0; m < 4; ++m) _Pragma("unroll") for (int k = 0; k < 2; ++k) dst[m][k] = *(const PG8_LAS bf16x8*)(lds + PG8_SA(b, h) + aoff + m * 2048 + k * 1024); } while (0)
#define PG8_LDB(dst, b, h) do { _Pragma("unroll") for (int n = 0; n < 2; ++n) _Pragma("unroll") for (int k = 0; k < 2; ++k) dst[n][k] = *(const PG8_LAS bf16x8*)(lds + PG8_SB(b, h) + boff + n * 2048 + k * 1024); } while (0)
#define PG8_MMA(ai, bj, At, Bt) do { __builtin_amdgcn_s_setprio(1); _Pragma("unroll") for (int m = 0; m < 4; ++m) _Pragma("unroll") for (int n = 0; n < 2; ++n) _Pragma("unroll") for (int k = 0; k < 2; ++k) \
        acc[ai][bj][m][n] = __builtin_amdgcn_mfma_f32_16x16x32_bf16(Bt[n][k], At[m][k], acc[ai][bj][m][n], 0, 0, 0); __builtin_amdgcn_s_setprio(0); } while (0)
#define PG8_WAIT_V(n) asm volatile("s_waitcnt vmcnt(" #n ")" ::: "memory")
#define PG8_WAIT_L(n) asm volatile("s_waitcnt lgkmcnt(" #n ")" ::: "memory")
#define PG8_BAR __builtin_amdgcn_s_barrier()
#define PG8_SCHED __builtin_amdgcn_sched_barrier(0)
    Unit cur, nxt; int ui = 0;
    if (!S.next(0, cur)) return;
    f32x4 acc[2][2][4][2];
#pragma unroll
    for (int a = 0; a < 2; ++a)
#pragma unroll
        for (int b = 0; b < 2; ++b)
#pragma unroll
            for (int m = 0; m < 4; ++m)
#pragma unroll
                for (int n = 0; n < 2; ++n) acc[a][b][m][n] = (f32x4){0.f, 0.f, 0.f, 0.f};
    bf16x8 At[4][2], B0[2][2], B1[2][2];
    const char* cA = (const char*)g.A + (size_t)cur.pm * tstepA; const char* cB = (const char*)g.Bt + (size_t)cur.pn * tstepB;
    S.a_ready(cur);
    if constexpr (SP2) {
        PG8_STAGE(PG8_SB(0, 0), cB, voffB); PG8_STAGE(PG8_SB(0, 1), cB + hstepB, voffB); PG8_STAGE(PG8_SA(0, 0), cA, voffA); PG8_STAGE(PG8_SA(0, 1), cA + hstepA, voffA);
        if (wr == 1) PG8_BAR;
        PG8_WAIT_V(2); PG8_BAR;
        PG8_STAGE(PG8_SB(1, 0), cB + kstep, voffB); PG8_STAGE(PG8_SA(1, 0), cA + kstep, voffA); PG8_STAGE(PG8_SB(1, 1), cB + hstepB + kstep, voffB);
        PG8_WAIT_V(6); PG8_BAR;
    } else {
        PG8_STAGE(PG8_SB(0, 0), cB, voffB); PG8_STAGE(PG8_SA(0, 0), cA, voffA); PG8_STAGE(PG8_SB(0, 1), cB + hstepB, voffB); PG8_STAGE(PG8_SA(0, 1), cA + hstepA, voffA);
        if (wr == 1) PG8_BAR;
        PG8_WAIT_V(4); PG8_BAR;
        PG8_STAGE(PG8_SB(1, 0), cB + kstep, voffB); PG8_STAGE(PG8_SA(1, 0), cA + kstep, voffA); PG8_STAGE(PG8_SB(1, 1), cB + hstepB + kstep, voffB);
        PG8_WAIT_V(6); PG8_BAR;
    }
    for (;;) {
        const bool has_next = S.next(ui + 1, nxt);
        const char* nA = has_next ? (const char*)g.A + (size_t)nxt.pm * tstepA : cA; const char* nB = has_next ? (const char*)g.Bt + (size_t)nxt.pn * tstepB : cB;
        for (int t = 0; t < nt; t += 2) {
            const bool last = (t == nt - 2);
            const char* a1 = cA + (size_t)(t + 1) * kstep;
            const char* a2 = last ? nA : cA + (size_t)(t + 2) * kstep; const char* b2 = last ? nB : cB + (size_t)(t + 2) * kstep;
            const char* a3 = a2 + kstep; const char* b3 = b2 + kstep;
            if (last && has_next) S.a_ready(nxt);
            if constexpr (SP2) {
            PG8_LDB(B0, 0, 0); PG8_LDB(B1, 0, 1); PG8_SCHED; PG8_LDA(At, 0, 0); PG8_STAGE(PG8_SA(1, 1), a1 + hstepA, voffA);
            PG8_WAIT_V(8); PG8_WAIT_L(0); PG8_BAR; PG8_MMA(0, 0, At, B0); PG8_MMA(0, 1, At, B1); PG8_BAR; PG8_SCHED;
            PG8_LDA(At, 0, 1); PG8_STAGE(PG8_SB(0, 0), b2, voffB); PG8_STAGE(PG8_SB(0, 1), b2 + hstepB, voffB); PG8_STAGE(PG8_SA(0, 0), a2, voffA);
            PG8_WAIT_V(8); PG8_WAIT_L(0); PG8_BAR; PG8_MMA(1, 0, At, B0); PG8_MMA(1, 1, At, B1); PG8_BAR; PG8_SCHED;
            PG8_LDB(B0, 1, 0); PG8_LDB(B1, 1, 1); PG8_SCHED; PG8_LDA(At, 1, 0); PG8_STAGE(PG8_SA(0, 1), a2 + hstepA, voffA);
            PG8_WAIT_V(8); PG8_WAIT_L(0); PG8_BAR; PG8_MMA(0, 0, At, B0); PG8_MMA(0, 1, At, B1); PG8_BAR; PG8_SCHED;
            PG8_LDA(At, 1, 1); PG8_STAGE(PG8_SB(1, 0), b3, voffB); PG8_STAGE(PG8_SB(1, 1), b3 + hstepB, voffB); PG8_STAGE(PG8_SA(1, 0), a3, voffA);
            PG8_WAIT_V(8); PG8_WAIT_L(0); PG8_BAR; PG8_MMA(1, 0, At, B0); PG8_MMA(1, 1, At, B1); PG8_BAR; PG8_SCHED;
            } else {
            PG8_LDB(B0, 0, 0); PG8_SCHED; PG8_LDA(At, 0, 0); PG8_STAGE(PG8_SA(1, 1), a1 + hstepA, voffA);
            PG8_WAIT_L(8); PG8_BAR; PG8_WAIT_L(0); PG8_MMA(0, 0, At, B0); PG8_BAR; PG8_SCHED;
            PG8_LDB(B1, 0, 1); PG8_STAGE(PG8_SB(0, 0), b2, voffB);
            PG8_BAR; PG8_WAIT_L(0); PG8_MMA(0, 1, At, B1); PG8_BAR;
            PG8_LDA(At, 0, 1); PG8_STAGE(PG8_SA(0, 0), a2, voffA);
            PG8_BAR; PG8_WAIT_L(0); PG8_MMA(1, 0, At, B0); PG8_BAR; PG8_SCHED;
            PG8_STAGE(PG8_SB(0, 1), b2 + hstepB, voffB);
            PG8_WAIT_V(6); PG8_BAR; PG8_MMA(1, 1, At, B1); PG8_BAR;
            PG8_LDB(B0, 1, 0); PG8_SCHED; PG8_LDA(At, 1, 0); PG8_STAGE(PG8_SA(0, 1), a2 + hstepA, voffA);
            PG8_WAIT_L(8); PG8_BAR; PG8_WAIT_L(0); PG8_MMA(0, 0, At, B0); PG8_BAR; PG8_SCHED;
            PG8_LDB(B1, 1, 1); PG8_STAGE(PG8_SB(1, 0), b3, voffB);
            PG8_BAR; PG8_WAIT_L(0); PG8_MMA(0, 1, At, B1); PG8_BAR;
            PG8_LDA(At, 1, 1); PG8_STAGE(PG8_SA(1, 0), a3, voffA);
            PG8_BAR; PG8_WAIT_L(0); PG8_MMA(1, 0, At, B0); PG8_BAR; PG8_SCHED;
            PG8_STAGE(PG8_SB(1, 1), b3 + hstepB, voffB);
            PG8_WAIT_V(6); PG8_BAR; PG8_MMA(1, 1, At, B1); PG8_BAR;
            }
        }
        if constexpr (ALIGN_EPI) { if (wr == 0) PG8_BAR; }
        if constexpr (!Epi::AFTER_DRAIN) { E(acc, cur, wr, wc, fr, fq); S.done(cur); }
        if (!has_next) break;
#pragma unroll
        for (int a = 0; a < 2; ++a)
#pragma unroll
            for (int b = 0; b < 2; ++b)
#pragma unroll
                for (int m = 0; m < 4; ++m)
#pragma unroll
                    for (int n = 0; n < 2; ++n) acc[a][b][m][n] = (f32x4){0.f, 0.f, 0.f, 0.f};
        cur = nxt; cA = nA; cB = nB; ++ui;
        if constexpr (ALIGN_EPI) { if (wr == 1) PG8_BAR; }
    }
    PG8_WAIT_V(0);
    if constexpr (!ALIGN_EPI) { if (wr == 0) PG8_BAR; }
    PG8_BAR;
#undef PG8_SA
#undef PG8_SB
#undef PG8_STAGE
#undef PG8_LDA
#undef PG8_LDB
#undef PG8_MMA
#undef PG8_WAIT_V
#undef PG8_WAIT_L
#undef PG8_BAR
#undef PG8_SCHED
}
}

constexpr int NWAVES = 8;
constexpr int BATCH = 8, SEQ = 4096, D = 1024, T = BATCH * SEQ;
constexpr int CONVD = 512, CONVW = 31, SBH = 8, SBD = 64, SBDIM = 512;
constexpr int PH = 8, NKEYS = 128, TOPK = 16, NEXP = NKEYS * NKEYS;
constexpr int NIN = 4096;
constexpr float LN_EPS = 1e-5f;
constexpr float ALPHA = 1.189207115002721f;
constexpr float QSCALE = 0.125f * 1.4426950408889634f;
constexpr int N_PHASES = 9;

constexpr size_t MiB = 1u << 20;
constexpr size_t WS_CTL = 0, CTL_ZERO_BYTES = 1 * MiB;
constexpr size_t WS_WIN = 2 * MiB;
constexpr size_t WS_WV = 10 * MiB;
constexpr size_t WS_WPW2 = 11 * MiB;
constexpr size_t WS_WO = 12 * MiB;
constexpr size_t WS_WOUT = 13 * MiB;
constexpr size_t WS_WEFF = 17 * MiB;
constexpr size_t WS_IDX = 21 * MiB;
constexpr size_t WS_GATE = 37 * MiB;
constexpr size_t WS_UT = 53 * MiB;
constexpr size_t WS_VTAB = 85 * MiB;
constexpr size_t WS_XB = 117 * MiB;
constexpr size_t WS_C = 181 * MiB;
constexpr size_t WS_AO = 213 * MiB;
constexpr size_t WS_GLU = 373 * MiB;
constexpr size_t WS_Q = 405 * MiB;
constexpr size_t WS_K = 437 * MiB;
constexpr size_t WS_VT = 469 * MiB;
constexpr size_t WS_M2 = 373 * MiB;
constexpr size_t WS_G = 245 * MiB;
constexpr size_t WS_R = 245 * MiB;
constexpr size_t WS_ST = 245 * MiB;
constexpr size_t WS_END = 501 * MiB;
constexpr int CW_BAR = 4096;

constexpr int RING_OFF = 0, RING_BYTES = 131072;
constexpr int LDSCTL_OFF = RING_BYTES, MISC_OFF = LDSCTL_OFF + 320;
constexpr int LDS_BYTES = 147456;

#define GAS __attribute__((address_space(1)))
#define LAS __attribute__((address_space(3)))
typedef unsigned short bf16;
typedef unsigned v4u __attribute__((ext_vector_type(4)));
typedef unsigned v2u __attribute__((ext_vector_type(2)));
typedef float f32x4 __attribute__((ext_vector_type(4)));
typedef float f32x16 __attribute__((ext_vector_type(16)));
typedef float f32x2 __attribute__((ext_vector_type(2)));
typedef short bf16x8 __attribute__((ext_vector_type(8)));
typedef GAS unsigned gu32;
#define RLX_AGENT __ATOMIC_RELAXED, __HIP_MEMORY_SCOPE_AGENT
#define LDS_WAIT() asm volatile("s_waitcnt lgkmcnt(0)" ::: "memory")
#define VM_WAIT() asm volatile("s_waitcnt vmcnt(0)" ::: "memory")
__device__ __forceinline__ unsigned f2bf(float f) { unsigned u = __builtin_bit_cast(unsigned, f); return (u + 0x7fffu + ((u >> 16) & 1u)) >> 16; }
__device__ __forceinline__ unsigned pk2(float lo, float hi) { return f2bf(lo) | (f2bf(hi) << 16); }
__device__ __forceinline__ float bflo(unsigned w) { return __uint_as_float(w << 16); }
__device__ __forceinline__ float bfhi(unsigned w) { return __uint_as_float(w & 0xffff0000u); }

#define XB_TMO      128
#define XB_XCNT(j)  (256  + 64 * (j))
#define XB_XSUB(j)  (1280 + 64 * (j))
#define XB_XGEN(j)  (2304 + 64 * (j))
#define XB_TOP      3328
#define XB_TOPGEN   3392
#define XCD_BAR_WORDS 3456
#define XB_SPIN_CAP (1u << 18)
__device__ __forceinline__ unsigned xb_ld(unsigned* p)              { return __hip_atomic_load(p, __ATOMIC_RELAXED, __HIP_MEMORY_SCOPE_AGENT); }
__device__ __forceinline__ unsigned xb_add(unsigned* p, unsigned v) { return __hip_atomic_fetch_add(p, v, __ATOMIC_RELAXED, __HIP_MEMORY_SCOPE_AGENT); }
__device__ __forceinline__ unsigned xb_xcc_id() { return (unsigned)__builtin_amdgcn_s_getreg((3 << 11) | 20) & 0xFu; }
#define XB_SPIN(cond, bar) do { unsigned _sp = 0; while (cond) { __builtin_amdgcn_s_sleep(1); \
    if ((++_sp & 255u) == 0u) { if (xb_ld(&(bar)[XB_TMO])) break; if (_sp > XB_SPIN_CAP) { atomicAdd(&(bar)[XB_TMO], 1u); break; } } } } while (0)
struct XcdBarrier { unsigned* bar; unsigned x; volatile LAS unsigned* st; };
__device__ __forceinline__ XcdBarrier xcd_barrier_post(unsigned* bar, volatile LAS unsigned* st) {
    XcdBarrier b; b.bar = bar; b.x = xb_xcc_id(); b.st = st;
    if (threadIdx.x == 0) (void)xb_add(&bar[XB_XCNT(b.x)], 1u);
    return b;
}
__device__ __forceinline__ void xcd_barrier_complete(unsigned* bar, unsigned x, unsigned& nloc, unsigned& nx) {
    const unsigned G = gridDim.x * gridDim.y * gridDim.z;
    unsigned sum, cnt, mine, sp = 0u;
    for (;;) {
        sum = 0u; cnt = 0u; mine = 0u;
#pragma unroll
        for (unsigned j = 0; j < 16; ++j) { const unsigned c = xb_ld(&bar[XB_XCNT(j)]); sum += c; cnt += (c > 0u) ? 1u : 0u; mine = (j == x) ? c : mine; }
        if (sum == G) break;
        __builtin_amdgcn_s_sleep(1);
        if ((++sp & 255u) == 0u) { if (xb_ld(&bar[XB_TMO])) break; if (sp > XB_SPIN_CAP) { atomicAdd(&bar[XB_TMO], 1u); break; } }
    }
    nloc = mine > 0u ? mine : 1u; nx = cnt > 0u ? cnt : 1u;
}
__device__ __forceinline__ void xcd_barrier(const XcdBarrier& b) {
    asm volatile("s_waitcnt vmcnt(0)" ::: "memory");
    __syncthreads();
    if (threadIdx.x == 0) {
        unsigned* bar = b.bar;
        __builtin_amdgcn_s_waitcnt(0);
        unsigned nloc = b.st[0], nx = b.st[1];
        if (nloc == 0u) { xcd_barrier_complete(bar, b.x, nloc, nx); b.st[0] = nloc; b.st[1] = nx; }
        const unsigned old = xb_add(&bar[XB_XSUB(b.x)], 1u);
        const unsigned gen = old / nloc;
        if (old + 1u == (gen + 1u) * nloc) {
            __builtin_amdgcn_fence(__ATOMIC_RELEASE, "agent");
            asm volatile("s_waitcnt vmcnt(0)" ::: "memory");
            const unsigned og = xb_add(&bar[XB_TOP], 1u);
            const unsigned tg = og / nx;
            if (og + 1u == (tg + 1u) * nx) xb_add(&bar[XB_TOPGEN], 1u);
            else XB_SPIN(xb_ld(&bar[XB_TOPGEN]) == tg, bar);
            __builtin_amdgcn_fence(__ATOMIC_ACQUIRE, "agent");
            xb_add(&bar[XB_XGEN(b.x)], 1u);
            asm volatile("s_waitcnt vmcnt(0)" ::: "memory");
        } else {
            XB_SPIN(xb_ld(&bar[XB_XGEN(b.x)]) == gen, bar);
            __builtin_amdgcn_fence(__ATOMIC_ACQUIRE, "agent");
            asm volatile("s_waitcnt vmcnt(0)" ::: "memory");
        }
    }
    __syncthreads();
}

struct Frame {
    LAS unsigned char* lds;
    volatile LAS unsigned* MISC;
    gu32* ctl;
    int tid, lane, wave;
    int vcu, G;
    const float *x, *w_in, *b_in, *cw_dw, *cb_dw, *cln_g, *cln_b, *w_pw2, *b_pw2, *w_o, *w_out, *b_out, *ln1_g, *ln1_b, *w_q, *keys1, *keys2, *pu, *pv, *ln2_g, *ln2_b;
    float* out;
    bf16 *WinT, *WvT, *Wpw2T, *WoT, *WoutT, *WeffT, *UT, *VTAB, *XB, *Cb, *AO, *GLU, *Qb, *Kb, *VT, *M2, *Gt;
    float *R, *ST, *GATE; int* IDX;
};

__device__ __forceinline__ float wave_sum(float v) {
#pragma unroll
    for (int o = 1; o < 64; o <<= 1) v += __shfl_xor(v, o);
    return v;
}

__device__ __forceinline__ void p0_transpose_item(const float* W, int ldw, int src_col0, int k0, bf16* WT, int ldt, int dst_row0, int dst_k0, LAS float* scr, int lane) {
#pragma unroll 8
    for (int i = 0; i < 32; ++i) { const int kk = 2 * i + (lane >> 5); scr[kk * 33 + (lane & 31)] = W[(size_t)(k0 + kk) * ldw + src_col0 + (lane & 31)]; }
    LDS_WAIT(); asm volatile("" ::: "memory");
    const int c = lane & 7;
#pragma unroll
    for (int j = 0; j < 4; ++j) { const int n = (lane >> 3) + 8 * j; const LAS float* s = scr + (8 * c) * 33 + n;
        v4u o; o.x = pk2(s[0 * 33], s[1 * 33]); o.y = pk2(s[2 * 33], s[3 * 33]); o.z = pk2(s[4 * 33], s[5 * 33]); o.w = pk2(s[6 * 33], s[7 * 33]);
        *(GAS v4u*)(WT + (size_t)(dst_row0 + n) * ldt + dst_k0 + 8 * c) = o; }
    LDS_WAIT(); asm volatile("" ::: "memory");
}
__device__ __forceinline__ void p0_convert(const float* src, bf16* dst, size_t n8, int gw, int NGW, int lane) {
    for (size_t i = (size_t)gw * 64 + lane; i < n8; i += (size_t)NGW * 64) {
        const f32x4 a = *(const GAS f32x4*)(src + i * 8), b = *(const GAS f32x4*)(src + i * 8 + 4);
        v4u o; o.x = pk2(a.x, a.y); o.y = pk2(a.z, a.w); o.z = pk2(b.x, b.y); o.w = pk2(b.z, b.w);
        *(GAS v4u*)(dst + i * 8) = o; }
}
__device__ __forceinline__ void p0_weff_tile(Frame& F, int tile) {
    const int lane = F.lane, r32 = lane & 31, hi = lane >> 5;
    const int it = tile & 31, kt = (tile >> 5) & 3, g = tile >> 7;
    const int h = g >> 1, half = g & 1;
    const float* kp = (half ? F.keys2 : F.keys1) + ((size_t)h * NKEYS + kt * 32 + r32) * 128 + 64 * hi;
    const float* wp = F.w_q + (size_t)(it * 32 + r32) * 2048 + g * 128 + 64 * hi;
    f32x4 a[16], b[16];
#pragma unroll
    for (int j = 0; j < 16; ++j) { a[j] = *(const GAS f32x4*)(kp + 4 * j); b[j] = *(const GAS f32x4*)(wp + 4 * j); }
    f32x16 c = {};
#pragma unroll
    for (int j = 0; j < 16; ++j)
#pragma unroll
        for (int e = 0; e < 4; ++e) c = __builtin_amdgcn_mfma_f32_32x32x2f32(a[j][e], b[j][e], c, 0, 0, 0);
#pragma unroll
    for (int r = 0; r < 16; ++r) { const int row = (r & 3) + 8 * (r >> 2) + 4 * hi;
        F.WeffT[(size_t)(g * 128 + kt * 32 + row) * 1024 + it * 32 + r32] = (bf16)f2bf(c[r]); }
}
__device__ __forceinline__ void p0_prologue(Frame& F) {
    LAS float* scr = (LAS float*)(F.lds + RING_OFF + F.wave * 16384);
    const int gw = F.vcu * NWAVES + F.wave, NGW = F.G * NWAVES;
    constexpr int I_IN = 16 * 128, I_V = 16 * 16, I_P = 8 * 32, I_O = 8 * 32, I_W = 16 * 32;
    constexpr int NITEMS = I_IN + I_V + I_P + I_O + I_W;
    for (int itx = gw; itx < NITEMS; itx += NGW) {
        int r = itx;
        if (r < I_IN) { const int kb = r / 128, nb = r % 128, j0 = nb * 32;
            int oc; if (j0 < 1024) { const int pn = j0 >> 8, w = j0 & 255; oc = (w < 128) ? pn * 128 + w : 512 + pn * 128 + (w - 128); } else if (j0 < 2048) oc = j0; else oc = j0 + 512;
            p0_transpose_item(F.w_in, 4608, oc, kb * 64, F.WinT, 1024, j0, kb * 64, scr, F.lane); continue; } r -= I_IN;
        if (r < I_V) { const int kb = r / 16, nb = r % 16; p0_transpose_item(F.w_in, 4608, 2048 + nb * 32, kb * 64, F.WvT, 1024, nb * 32, kb * 64, scr, F.lane); continue; } r -= I_V;
        if (r < I_P) { const int kb = r / 32, nb = r % 32; p0_transpose_item(F.w_pw2, 1024, nb * 32, kb * 64, F.Wpw2T, 512, nb * 32, kb * 64, scr, F.lane); continue; } r -= I_P;
        if (r < I_O) { const int kb = r / 32, nb = r % 32; p0_transpose_item(F.w_o, 1024, nb * 32, kb * 64, F.WoT, 512, nb * 32, kb * 64, scr, F.lane); continue; } r -= I_O;
        { const int kb = r / 32, nb = r % 32; p0_transpose_item(F.w_out, 1024, nb * 32, kb * 64, F.WoutT, 2048, nb * 32, kb * 64, scr, F.lane);
          p0_transpose_item(F.w_out, 1024, nb * 32, kb * 64, F.WoutT, 2048, nb * 32, 1024 + kb * 64, scr, F.lane); }
    }
    for (int tile = gw; tile < 2048; tile += NGW) p0_weff_tile(F, tile);
    p0_convert(F.x, F.XB, (size_t)T * D / 8, gw, NGW, F.lane);
    p0_convert(F.pu, F.UT, (size_t)NEXP * D / 8, gw, NGW, F.lane);
    p0_convert(F.pv, F.VTAB, (size_t)NEXP * D / 8, gw, NGW, F.lane);
}

__device__ __forceinline__ void conv_unit(Frame& F, int ct) {
    const int tid = F.tid, lane = F.lane, w = F.wave;
    const int tb = ct * 64, p0 = tb & (SEQ - 1);
    LAS unsigned char* L = F.lds + RING_OFF;
    for (int c = tid; c < 94 * 64; c += NWAVES * 64) { const int r = c >> 6, ch = c & 63; v4u v = (v4u){0u, 0u, 0u, 0u};
        if (p0 - 30 + r >= 0) v = *(const GAS v4u*)(F.GLU + (size_t)(tb - 30 + r) * CONVD + ch * 8);
        *(LAS v4u*)(L + r * 1024 + ch * 16) = v; }
    __syncthreads();
    float s1[8], s2[8];
#pragma unroll
    for (int i = 0; i < 8; ++i) { s1[i] = 0.f; s2[i] = 0.f; }
#define CONV_BODY() \
        const int p = lane + 64 * q, c0 = 2 * p; \
        const f32x2 bb = *(const GAS f32x2*)(F.cb_dw + c0); \
        float a0[8], a1[8]; \
        _Pragma("unroll") for (int i = 0; i < 8; ++i) { a0[i] = bb.x; a1[i] = bb.y; } \
        float w0[CONVW], w1[CONVW]; \
        _Pragma("unroll") for (int rr = 0; rr < 38; ++rr) { \
            if (rr < CONVW) { const f32x2 ww = *(const GAS f32x2*)(F.cw_dw + rr * CONVD + c0); w0[rr] = ww.x; w1[rr] = ww.y; } \
            const unsigned g2 = *(const LAS unsigned*)(L + (8 * w + rr) * 1024 + p * 4); \
            const float lo = bflo(g2), hi = bfhi(g2); \
            _Pragma("unroll") for (int i = 0; i < 8; ++i) { const int j = rr - i; if (j >= 0 && j < CONVW) { a0[i] += w0[j] * lo; a1[i] += w1[j] * hi; } } \
        }
#pragma unroll 1
    for (int q = 0; q < 4; ++q) {
        CONV_BODY()
#pragma unroll
        for (int i = 0; i < 8; ++i) { s1[i] += a0[i] + a1[i]; s2[i] += a0[i] * a0[i] + a1[i] * a1[i]; }
    }
    float mean[8], rstd[8];
#pragma unroll
    for (int i = 0; i < 8; ++i) { mean[i] = wave_sum(s1[i]) * (1.0f / CONVD); const float var = wave_sum(s2[i]) * (1.0f / CONVD) - mean[i] * mean[i];
        rstd[i] = 1.0f / sqrtf(fmaxf(var, 0.f) + LN_EPS); }
#pragma unroll 1
    for (int q = 0; q < 4; ++q) {
        CONV_BODY()
        const f32x2 gg = *(const GAS f32x2*)(F.cln_g + c0), lb = *(const GAS f32x2*)(F.cln_b + c0);
#pragma unroll
        for (int i = 0; i < 8; ++i) { float v0 = (a0[i] - mean[i]) * rstd[i] * gg.x + lb.x, v1 = (a1[i] - mean[i]) * rstd[i] * gg.y + lb.y;
            v0 = v0 * pg8::sigmoid_f(v0); v1 = v1 * pg8::sigmoid_f(v1);
            *(GAS unsigned*)(F.Cb + (size_t)(tb + 8 * w + i) * CONVD + c0) = pk2(v0, v1); }
    }
#undef CONV_BODY
    __syncthreads();
}

__device__ __forceinline__ unsigned cvtpk_s(float lo, float hi) { typedef float f2 __attribute__((ext_vector_type(2))); typedef __bf16 b2 __attribute__((ext_vector_type(2))); f2 v = {lo, hi}; b2 b = __builtin_convertvector(v, b2); return __builtin_bit_cast(unsigned, b); }
__device__ __forceinline__ void attn_task(Frame& F, int task) {
    const int lane = F.lane, r32 = lane & 31, hi = lane >> 5;
    const int qblk = task & 127, h = (task >> 7) & 7, b = task >> 10;
    const int q0 = qblk * 32; const size_t rowbase = (size_t)b * SEQ;
    bf16x8 qf[4];
#pragma unroll
    for (int d0 = 0; d0 < 4; ++d0) qf[d0] = *(const GAS bf16x8*)(F.Qb + (rowbase + q0 + r32) * SBDIM + h * SBD + d0 * 16 + hi * 8);
    f32x16 o0 = {}, o1 = {};
    float Rc = 1.0f;
    const int kperm = 32 * ((r32 >> 2) & 1) + 4 * (r32 >> 3) + (r32 & 3);
    const int jt0 = q0 >> 6;
    const int qpos = q0 + r32;
    for (int jt = jt0; jt >= 0; --jt) {
        const int t0 = jt * 64;
        bf16x8 kf[2][4];
#pragma unroll
        for (int p = 0; p < 2; ++p)
#pragma unroll
            for (int d0 = 0; d0 < 4; ++d0) kf[p][d0] = *(const GAS bf16x8*)(F.Kb + (rowbase + t0 + kperm + 16 * p) * SBDIM + h * SBD + d0 * 16 + hi * 8);
        bf16x8 vf[2][2][2];
#pragma unroll
        for (int dt = 0; dt < 2; ++dt)
#pragma unroll
            for (int p = 0; p < 2; ++p)
#pragma unroll
                for (int s = 0; s < 2; ++s) vf[dt][p][s] = *(const GAS bf16x8*)(F.VT + (size_t)(h * SBD + dt * 32 + r32) * T + rowbase + t0 + 32 * hi + 16 * p + 8 * s);
        f32x16 sp[2];
#pragma unroll
        for (int p = 0; p < 2; ++p) { sp[p] = (f32x16){};
#pragma unroll
            for (int d0 = 0; d0 < 4; ++d0) sp[p] = __builtin_amdgcn_mfma_f32_32x32x16_bf16(kf[p][d0], qf[d0], sp[p], 0, 0, 0); }
        float rr[32], be[32];
#pragma unroll
        for (int p = 0; p < 2; ++p)
#pragma unroll
            for (int r = 0; r < 16; ++r) { const float e = __builtin_amdgcn_exp2f(sp[p][r]); const float om = __builtin_amdgcn_rcpf(1.0f + e); rr[16 * p + r] = om; be[16 * p + r] = 1.0f - om; }
        if (jt == jt0) {
#pragma unroll
            for (int i = 0; i < 32; ++i) { const bool valid = (t0 + 32 * hi + i) < qpos; rr[i] = valid ? rr[i] : 1.0f; be[i] = valid ? be[i] : 0.0f; }
        }
        float tt[16];
#pragma unroll
        for (int i = 0; i < 16; ++i) tt[i] = rr[2 * i] * rr[2 * i + 1];
#pragma unroll
        for (int i = 0; i < 8; ++i) tt[i] = tt[2 * i] * tt[2 * i + 1];
#pragma unroll
        for (int i = 0; i < 4; ++i) tt[i] = tt[2 * i] * tt[2 * i + 1];
        const float tot = (tt[0] * tt[1]) * (tt[2] * tt[3]);
        const float oth = __shfl_xor(tot, 32);
        float run = hi ? Rc : Rc * oth;
        Rc = Rc * tot * oth;
        float pa[32];
#pragma unroll
        for (int i = 31; i >= 0; --i) { pa[i] = be[i] * run; run *= rr[i]; }
#pragma unroll
        for (int p = 0; p < 2; ++p)
#pragma unroll
            for (int s = 0; s < 2; ++s) { v4u pw; const int bs = 16 * p + 8 * s;
                pw.x = cvtpk_s(pa[bs], pa[bs + 1]); pw.y = cvtpk_s(pa[bs + 2], pa[bs + 3]); pw.z = cvtpk_s(pa[bs + 4], pa[bs + 5]); pw.w = cvtpk_s(pa[bs + 6], pa[bs + 7]);
                const bf16x8 pf = __builtin_bit_cast(bf16x8, pw);
                o0 = __builtin_amdgcn_mfma_f32_32x32x16_bf16(pf, vf[0][p][s], o0, 0, 0, 0);
                o1 = __builtin_amdgcn_mfma_f32_32x32x16_bf16(pf, vf[1][p][s], o1, 0, 0, 0); }
        if (__all(Rc < 1e-12f)) break;
    }
#pragma unroll
    for (int r = 0; r < 16; ++r) { const int q = (r & 3) + 8 * (r >> 2) + 4 * hi; bf16* op = F.AO + (rowbase + q0 + q) * SBDIM + h * SBD + r32;
        op[0] = (bf16)f2bf(o0[r]); op[32] = (bf16)f2bf(o1[r]); }
}

__device__ __forceinline__ void ln1_row(Frame& F, int m) {
    const GAS f32x4* xr = (const GAS f32x4*)(F.R + (size_t)m * D) + F.lane;
    f32x4 v[4]; float s = 0.f;
#pragma unroll
    for (int j = 0; j < 4; ++j) { v[j] = xr[64 * j]; s += (v[j].x + v[j].y) + (v[j].z + v[j].w); }
    const float mean = wave_sum(s) * (1.f / D); float s2 = 0.f;
#pragma unroll
    for (int j = 0; j < 4; ++j) { v[j] = v[j] - mean; s2 += (v[j].x * v[j].x + v[j].y * v[j].y) + (v[j].z * v[j].z + v[j].w * v[j].w); }
    const float rstd = 1.f / sqrtf(wave_sum(s2) * (1.f / D) + LN_EPS);
    GAS v2u* o8 = (GAS v2u*)(F.XB + (size_t)m * D) + F.lane;
#pragma unroll
    for (int j = 0; j < 4; ++j) { const f32x4 gg = *((const GAS f32x4*)F.ln1_g + F.lane + 64 * j), bb = *((const GAS f32x4*)F.ln1_b + F.lane + 64 * j);
        const f32x4 y = v[j] * rstd * gg + bb; v2u o; o.x = pk2(y.x, y.y); o.y = pk2(y.z, y.w); o8[64 * j] = o; }
}

#define CE_DESC(a, b) do { const unsigned _x = (a), _y = (b); (a) = _x > _y ? _x : _y; (b) = _x > _y ? _y : _x; } while (0)
__device__ __forceinline__ unsigned f2key(float f) { const unsigned u = __float_as_uint(f); return (u & 0x80000000u) ? ~u : (u | 0x80000000u); }
__device__ __forceinline__ float key2f(unsigned k) { const unsigned u = (k & 0x80000000u) ? (k & 0x7fffffffu) : ~k; return __uint_as_float(u); }
__device__ __forceinline__ void sort16_desc(unsigned (&a)[16]) {
#pragma unroll
    for (int k = 2; k <= 16; k <<= 1)
#pragma unroll
        for (int j = k >> 1; j > 0; j >>= 1)
#pragma unroll
            for (int i = 0; i < 16; ++i) { const int l = i ^ j; if (l > i) { if ((i & k) == 0) CE_DESC(a[i], a[l]); else CE_DESC(a[l], a[i]); } }
}
__device__ __forceinline__ void merge16_desc(unsigned (&t)[16], const unsigned (&c)[16]) {
#pragma unroll
    for (int i = 0; i < 16; ++i) t[i] = t[i] > c[15 - i] ? t[i] : c[15 - i];
#pragma unroll
    for (int j = 8; j > 0; j >>= 1)
#pragma unroll
        for (int i = 0; i < 16; ++i) { const int l = i ^ j; if (l > i) CE_DESC(t[i], t[l]); }
}
__device__ __forceinline__ void top16_of_128(const float* col, unsigned (&top)[16]) {
#pragma unroll 1
    for (int c = 0; c < 8; ++c) {
        unsigned a[16];
#pragma unroll
        for (int i = 0; i < 16; ++i) { const float v = *(const GAS float*)(col + (size_t)(c * 16 + i) * T); a[i] = (f2key(v) & ~127u) | (unsigned)(127 - (c * 16 + i)); }
        sort16_desc(a);
        if (c == 0) {
#pragma unroll
            for (int i = 0; i < 16; ++i) top[i] = a[i];
        } else merge16_desc(top, a);
    }
}
__device__ __forceinline__ void select_task(Frame& F, int task) {
    const int lane = F.lane, w = F.wave;
    const int h = task & 7, tblk = task >> 3; const int t = tblk * 64 + lane;
    unsigned v1[16], v2[16];
    top16_of_128(F.ST + (size_t)(h * 256) * T + t, v1);
    top16_of_128(F.ST + (size_t)(h * 256 + 128) * T + t, v2);
    LAS unsigned* L = (LAS unsigned*)(F.lds + RING_OFF) + w * 2048;
#pragma unroll
    for (int i = 0; i < 16; ++i) { L[i * 64 + lane] = v1[i]; L[(16 + i) * 64 + lane] = v2[i]; }
    float f1[16], f2[16];
#pragma unroll
    for (int i = 0; i < 16; ++i) { f1[i] = key2f(v1[i] & ~127u); f2[i] = key2f(v2[i] & ~127u); }
    unsigned top[16], cg[16];
#define CAND(i, j) ((f2key(f1[i] + f2[j]) & ~255u) | (unsigned)((i) * 16 + (j)))
#pragma unroll
    for (int j = 0; j < 16; ++j) top[j] = CAND(0, j);
    sort16_desc(top);
#pragma unroll
    for (int j = 0; j < 8; ++j) { cg[j] = CAND(1, j); cg[8 + j] = CAND(8 + j, 0); }
    sort16_desc(cg); merge16_desc(top, cg);
    cg[0] = CAND(2, 0); cg[1] = CAND(2, 1); cg[2] = CAND(2, 2); cg[3] = CAND(2, 3); cg[4] = CAND(2, 4);
    cg[5] = CAND(3, 0); cg[6] = CAND(3, 1); cg[7] = CAND(3, 2); cg[8] = CAND(3, 3);
    cg[9] = CAND(4, 0); cg[10] = CAND(4, 1); cg[11] = CAND(4, 2);
    cg[12] = CAND(5, 0); cg[13] = CAND(5, 1); cg[14] = CAND(6, 0); cg[15] = CAND(6, 1);
    sort16_desc(cg); merge16_desc(top, cg);
    cg[0] = CAND(7, 0); cg[1] = CAND(7, 1);
#pragma unroll
    for (int j = 2; j < 16; ++j) cg[j] = 0u;
    sort16_desc(cg); merge16_desc(top, cg);
#undef CAND
    LDS_WAIT(); asm volatile("" ::: "memory");
    float sv[16]; int ex[16];
#pragma unroll
    for (int j = 0; j < 16; ++j) { const unsigned k = top[j]; const int ci = (k >> 4) & 15, cj = k & 15;
        sv[j] = key2f(k & ~255u);
        const unsigned a = L[ci * 64 + lane], bq = L[(16 + cj) * 64 + lane];
        ex[j] = (127 - (int)(a & 127u)) * NKEYS + (127 - (int)(bq & 127u)); }
    float mx = sv[0], sum = 0.f;
#pragma unroll
    for (int j = 0; j < 16; ++j) { sv[j] = __builtin_amdgcn_exp2f((sv[j] - mx) * 1.4426950408889634f); sum += sv[j]; }
    const float inv = 1.0f / sum;
    GAS v4u* ip = (GAS v4u*)(F.IDX + (size_t)t * 128 + h * 16); GAS f32x4* gp = (GAS f32x4*)(F.GATE + (size_t)t * 128 + h * 16);
#pragma unroll
    for (int j = 0; j < 4; ++j) { ip[j] = (v4u){(unsigned)ex[4 * j], (unsigned)ex[4 * j + 1], (unsigned)ex[4 * j + 2], (unsigned)ex[4 * j + 3]};
        gp[j] = (f32x4){sv[4 * j] * inv, sv[4 * j + 1] * inv, sv[4 * j + 2] * inv, sv[4 * j + 3] * inv}; }
    LDS_WAIT(); asm volatile("" ::: "memory");
}

__device__ __forceinline__ float dot2bf(unsigned a, unsigned b, float acc) {
    typedef __bf16 b2 __attribute__((ext_vector_type(2)));
    return __builtin_amdgcn_fdot2_f32_bf16(__builtin_bit_cast(b2, a), __builtin_bit_cast(b2, b), acc, false);
}
__device__ __forceinline__ float gelu_erf(float v) {
    const float av = fabsf(v), t = __builtin_amdgcn_rcpf(av * 0.2316418882f + 1.0f);
    float q = t * 0.5307027145f + (-0.7265760135f); q = q * t + 0.7107068705f; q = q * t + (-0.142248368f); q = q * t + 0.127414796f; q = q * t;
    const float e = __builtin_amdgcn_exp2f((v * v) * (-0.72134752044f));
    const float m = v * (q * e);
    return v < 0.f ? m : v - m;
}
__device__ __forceinline__ void peer_token(Frame& F, int t) {
    const int lane = F.lane, grp = lane >> 4, i16 = lane & 15;
    LAS int* Lidx = (LAS int*)(F.lds + RING_OFF + F.wave * 2048);
    LAS float* Lco = (LAS float*)(Lidx + 128);
    LAS float* Lgate = (LAS float*)(Lidx + 256);
    Lidx[lane] = F.IDX[(size_t)t * 128 + lane]; Lidx[lane + 64] = F.IDX[(size_t)t * 128 + 64 + lane];
    Lgate[lane] = F.GATE[(size_t)t * 128 + lane]; Lgate[lane + 64] = F.GATE[(size_t)t * 128 + 64 + lane];
    v4u xp[8];
    const GAS v4u* xrow = (const GAS v4u*)(F.XB + (size_t)t * D) + i16;
#pragma unroll
    for (int j = 0; j < 8; ++j) xp[j] = xrow[j * 16];
    LDS_WAIT(); asm volatile("" ::: "memory");
    v4u ua[8], ub[8];
    { const int e = Lidx[grp]; const GAS v4u* up = (const GAS v4u*)(F.UT + (size_t)e * D) + i16;
#pragma unroll
      for (int j = 0; j < 8; ++j) ua[j] = up[j * 16]; }
#define U_STEP(cur, nxt, itn) do { \
        if ((itn) + 1 < 32) { const int e_ = Lidx[((itn) + 1) * 4 + grp]; const GAS v4u* up_ = (const GAS v4u*)(F.UT + (size_t)e_ * D) + i16; \
            _Pragma("unroll") for (int j = 0; j < 8; ++j) nxt[j] = up_[j * 16]; } \
        float d_ = 0.f; \
        _Pragma("unroll") for (int j = 0; j < 8; ++j) { d_ = dot2bf(cur[j].x, xp[j].x, d_); d_ = dot2bf(cur[j].y, xp[j].y, d_); d_ = dot2bf(cur[j].z, xp[j].z, d_); d_ = dot2bf(cur[j].w, xp[j].w, d_); } \
        d_ += __shfl_xor(d_, 1); d_ += __shfl_xor(d_, 2); d_ += __shfl_xor(d_, 4); d_ += __shfl_xor(d_, 8); \
        if (i16 == 0) Lco[(itn) * 4 + grp] = d_; } while (0)
#pragma unroll 1
    for (int it = 0; it < 32; it += 2) { U_STEP(ua, ub, it); U_STEP(ub, ua, it + 1); }
#undef U_STEP
    LDS_WAIT(); asm volatile("" ::: "memory");
    { const float c0 = Lgate[lane] * gelu_erf(Lco[lane]), c1 = Lgate[lane + 64] * gelu_erf(Lco[lane + 64]);
      Lco[lane] = c0; Lco[lane + 64] = c1; }
    LDS_WAIT(); asm volatile("" ::: "memory");
    float acc[64];
#pragma unroll
    for (int k = 0; k < 64; ++k) acc[k] = 0.f;
    { const int e = Lidx[grp]; const GAS v4u* vp = (const GAS v4u*)(F.VTAB + (size_t)e * D) + i16;
#pragma unroll
      for (int j = 0; j < 8; ++j) ua[j] = vp[j * 16]; }
#define V_STEP(cur, nxt, itn) do { \
        if ((itn) + 1 < 32) { const int e_ = Lidx[((itn) + 1) * 4 + grp]; const GAS v4u* vp_ = (const GAS v4u*)(F.VTAB + (size_t)e_ * D) + i16; \
            _Pragma("unroll") for (int j = 0; j < 8; ++j) nxt[j] = vp_[j * 16]; } \
        const float cf_ = Lco[(itn) * 4 + grp]; \
        _Pragma("unroll") for (int j = 0; j < 8; ++j) { \
            acc[8 * j + 0] += cf_ * bflo(cur[j].x); acc[8 * j + 1] += cf_ * bfhi(cur[j].x); acc[8 * j + 2] += cf_ * bflo(cur[j].y); acc[8 * j + 3] += cf_ * bfhi(cur[j].y); \
            acc[8 * j + 4] += cf_ * bflo(cur[j].z); acc[8 * j + 5] += cf_ * bfhi(cur[j].z); acc[8 * j + 6] += cf_ * bflo(cur[j].w); acc[8 * j + 7] += cf_ * bfhi(cur[j].w); } } while (0)
#pragma unroll 1
    for (int it = 0; it < 32; it += 2) { V_STEP(ua, ub, it); V_STEP(ub, ua, it + 1); }
#undef V_STEP
#pragma unroll
    for (int k = 0; k < 64; ++k) { acc[k] += __shfl_xor(acc[k], 16); acc[k] += __shfl_xor(acc[k], 32); }
    float s = 0.f;
#pragma unroll
    for (int j = 0; j < 8; ++j) {
        acc[8 * j + 0] += ALPHA * bflo(xp[j].x); acc[8 * j + 1] += ALPHA * bfhi(xp[j].x); acc[8 * j + 2] += ALPHA * bflo(xp[j].y); acc[8 * j + 3] += ALPHA * bfhi(xp[j].y);
        acc[8 * j + 4] += ALPHA * bflo(xp[j].z); acc[8 * j + 5] += ALPHA * bfhi(xp[j].z); acc[8 * j + 6] += ALPHA * bflo(xp[j].w); acc[8 * j + 7] += ALPHA * bfhi(xp[j].w); }
#pragma unroll
    for (int k = 0; k < 64; ++k) s += acc[k];
    s += __shfl_xor(s, 1); s += __shfl_xor(s, 2); s += __shfl_xor(s, 4); s += __shfl_xor(s, 8);
    const float mean = s * (1.0f / D); float s2 = 0.f;
#pragma unroll
    for (int k = 0; k < 64; ++k) { acc[k] -= mean; s2 += acc[k] * acc[k]; }
    s2 += __shfl_xor(s2, 1); s2 += __shfl_xor(s2, 2); s2 += __shfl_xor(s2, 4); s2 += __shfl_xor(s2, 8);
    const float rstd = 1.0f / sqrtf(s2 * (1.0f / D) + LN_EPS);
#pragma unroll
    for (int j = 0; j < 8; ++j) if ((j >> 1) == grp) {
        const int col = j * 128 + i16 * 8;
        const f32x4 g0 = *(const GAS f32x4*)(F.ln2_g + col), g1 = *(const GAS f32x4*)(F.ln2_g + col + 4), b0 = *(const GAS f32x4*)(F.ln2_b + col), b1 = *(const GAS f32x4*)(F.ln2_b + col + 4);
        f32x4 y0, y1;
        y0.x = acc[8 * j + 0] * rstd * g0.x + b0.x; y0.y = acc[8 * j + 1] * rstd * g0.y + b0.y; y0.z = acc[8 * j + 2] * rstd * g0.z + b0.z; y0.w = acc[8 * j + 3] * rstd * g0.w + b0.w;
        y1.x = acc[8 * j + 4] * rstd * g1.x + b1.x; y1.y = acc[8 * j + 5] * rstd * g1.y + b1.y; y1.z = acc[8 * j + 6] * rstd * g1.z + b1.z; y1.w = acc[8 * j + 7] * rstd * g1.w + b1.w;
        *(GAS f32x4*)(F.out + (size_t)t * D + col) = y0; *(GAS f32x4*)(F.out + (size_t)t * D + col + 4) = y1; }
    LDS_WAIT(); asm volatile("" ::: "memory");
}

struct Args { const float* in[21]; float* out; unsigned char* ws; int ph_lo, ph_hi, li, pad; };
__global__ void __launch_bounds__(NWAVES * 64, 2) fwd_kernel(Args args) {
    extern __shared__ __attribute__((aligned(16))) unsigned char lds[];
    Frame F;
    F.lds = (LAS unsigned char*)lds;
    F.MISC = (volatile LAS unsigned*)(F.lds + MISC_OFF);
    F.tid = threadIdx.x; F.lane = F.tid & 63; F.wave = __builtin_amdgcn_readfirstlane(F.tid >> 6);
    F.G = gridDim.x; { const int bx = blockIdx.x; F.vcu = (F.G % 8 == 0) ? (bx % 8) * (F.G / 8) + bx / 8 : bx; }
    unsigned char* ws = args.ws;
    F.ctl = (gu32*)(ws + WS_CTL);
    F.x = args.in[0]; F.w_in = args.in[1]; F.b_in = args.in[2]; F.cw_dw = args.in[3]; F.cb_dw = args.in[4]; F.cln_g = args.in[5]; F.cln_b = args.in[6];
    F.w_pw2 = args.in[7]; F.b_pw2 = args.in[8]; F.w_o = args.in[9]; F.w_out = args.in[10]; F.b_out = args.in[11]; F.ln1_g = args.in[12]; F.ln1_b = args.in[13];
    F.w_q = args.in[14]; F.keys1 = args.in[15]; F.keys2 = args.in[16]; F.pu = args.in[17]; F.pv = args.in[18]; F.ln2_g = args.in[19]; F.ln2_b = args.in[20];
    F.out = args.out;
    F.WinT = (bf16*)(ws + WS_WIN); F.WvT = (bf16*)(ws + WS_WV); F.Wpw2T = (bf16*)(ws + WS_WPW2); F.WoT = (bf16*)(ws + WS_WO); F.WoutT = (bf16*)(ws + WS_WOUT); F.WeffT = (bf16*)(ws + WS_WEFF);
    F.UT = (bf16*)(ws + WS_UT); F.VTAB = (bf16*)(ws + WS_VTAB); F.XB = (bf16*)(ws + WS_XB); F.Cb = (bf16*)(ws + WS_C); F.AO = (bf16*)(ws + WS_AO);
    F.GLU = (bf16*)(ws + WS_GLU); F.Qb = (bf16*)(ws + WS_Q); F.Kb = (bf16*)(ws + WS_K); F.VT = (bf16*)(ws + WS_VT); F.M2 = (bf16*)(ws + WS_M2); F.Gt = (bf16*)(ws + WS_G);
    F.R = (float*)(ws + WS_R); F.ST = (float*)(ws + WS_ST); F.GATE = (float*)(ws + WS_GATE); F.IDX = (int*)(ws + WS_IDX);
    for (int u = F.tid; u < (LDS_BYTES - LDSCTL_OFF) / 4; u += NWAVES * 64) ((LAS unsigned*)(F.lds + LDSCTL_OFF))[u] = 0u;
    __syncthreads();
    XcdBarrier bar; bar.bar = (unsigned*)(F.ctl + CW_BAR); bar.x = 0; bar.st = nullptr;
    if (MK_N_LAUNCHES == 1) bar = xcd_barrier_post((unsigned*)(F.ctl + CW_BAR), F.MISC + 8);
#define GRID_BAR() do { if (MK_N_LAUNCHES == 1) xcd_barrier(bar); } while (0)
    const int lo = args.ph_lo, hi = args.ph_hi;
#ifdef ONLY_PHASE
#define IN(k) ((k) == ONLY_PHASE && lo <= (k) && (k) < hi)
#elif defined(DBG_STOP)
#define IN(k) ((k) <= DBG_STOP && lo <= (k) && (k) < hi)
#else
#define IN(k) (lo <= (k) && (k) < hi)
#endif
#define BOTH(k) (IN(k) && IN((k) + 1))
    const int gw = F.vcu * NWAVES + F.wave, NGW = F.G * NWAVES;

    if (IN(0)) { p0_prologue(F); if (BOTH(0)) GRID_BAR(); }

    if (IN(1)) {
        { pg8::Gemm g{F.XB, F.WinT, T, NIN, D, D, D}; pg8::StaticOrder S; S.init(T, NIN, F.G, (int)blockIdx.x);
          pg8::EpiIn E{F.b_in, F.GLU, F.Qb, F.Kb, F.Gt, QSCALE};
          pg8::gemm_phase<pg8::EpiIn, pg8::StaticOrder, true, true>(F.lds + RING_OFF, g, S, E); }
        { pg8::Gemm g{F.WvT, F.XB, SBDIM, T, D, D, D}; pg8::StaticOrder S; S.init(SBDIM, T, F.G, (int)blockIdx.x);
          pg8::EpiVT E{F.b_in + 2048, F.VT, T};
          __syncthreads();
          pg8::gemm_phase<pg8::EpiVT, pg8::StaticOrder, false, true>(F.lds + RING_OFF, g, S, E); }
        if (BOTH(1)) GRID_BAR();
    }

    if (IN(2)) {
        for (int ct = F.vcu; ct < T / 64; ct += F.G) conv_unit(F, ct);
        for (int task = gw; task < BATCH * SBH * (SEQ / 32); task += NGW) attn_task(F, task);
        if (BOTH(2)) GRID_BAR();
    }

    if (IN(3)) {
        { pg8::Gemm g{F.Cb, F.Wpw2T, T, D, CONVD, CONVD, CONVD}; pg8::StaticOrder S; S.init(T, D, F.G, (int)blockIdx.x);
          pg8::EpiGate E{F.b_pw2, F.Gt, F.M2, 0, 0};
          pg8::gemm_phase<pg8::EpiGate, pg8::StaticOrder, true, true>(F.lds + RING_OFF, g, S, E); }
        { pg8::Gemm g{F.AO, F.WoT, T, D, SBDIM, SBDIM, SBDIM}; pg8::StaticOrder S; S.init(T, D, F.G, (int)blockIdx.x);
          pg8::EpiGate E{nullptr, F.Gt, F.M2, 1024, 1024};
          pg8::gemm_phase<pg8::EpiGate, pg8::StaticOrder, true, true>(F.lds + RING_OFF, g, S, E); }
        if (BOTH(3)) GRID_BAR();
    }

    if (IN(4)) {
        pg8::Gemm g{F.M2, F.WoutT, T, D, 2048, 2048, 2048}; pg8::StaticOrder S; S.init(T, D, F.G, (int)blockIdx.x);
        pg8::EpiRes E{F.R, F.x, F.b_out, ALPHA, D};
        pg8::gemm_phase<pg8::EpiRes, pg8::StaticOrder, true, true>(F.lds + RING_OFF, g, S, E);
        if (BOTH(4)) GRID_BAR();
    }

    if (IN(5)) {
        for (int m = gw; m < T; m += NGW) ln1_row(F, m);
        if (BOTH(5)) GRID_BAR();
    }

    if (IN(6)) {
        pg8::Gemm g{F.WeffT, F.XB, 2048, T, D, D, D}; pg8::StaticOrder S; S.init(2048, T, F.G, (int)blockIdx.x);
        pg8::EpiF32 E{F.ST, T};
        pg8::gemm_phase<pg8::EpiF32, pg8::StaticOrder, true, true>(F.lds + RING_OFF, g, S, E);
        if (BOTH(6)) GRID_BAR();
    }

    if (IN(7)) {
        for (int task = gw; task < (T / 64) * PH; task += NGW) select_task(F, task);
        if (BOTH(7)) GRID_BAR();
    }

    if (IN(8)) {
        for (int t = gw; t < T; t += NGW) peer_token(F, t);
    }
#ifdef DBG_STOP
    if (lo <= 8 && 8 < hi) {
        GRID_BAR();
        { const unsigned long long t0 = __builtin_amdgcn_s_memrealtime(); while (__builtin_amdgcn_s_memrealtime() - t0 < 30000ull) __builtin_amdgcn_s_sleep(32); }
        GRID_BAR();
        const size_t n4 = (size_t)T * D / 4;
        for (size_t i = (size_t)gw * 64 + F.lane; i < n4; i += (size_t)NGW * 64) {
            f32x4 v = (f32x4){0.f, 0.f, 0.f, 0.f};
            if (DBG_STOP == 4) { v = ((const GAS f32x4*)F.R)[i]; v = (f32x4){bflo(f2bf(v.x)), bflo(f2bf(v.y)), bflo(f2bf(v.z)), bflo(f2bf(v.w))}; }
            else if (DBG_STOP == 3) { const v2u w = ((const GAS v2u*)F.M2)[i]; const v2u w2 = ((const GAS v2u*)F.M2)[i + n4]; v = (f32x4){bflo(w.x) + bflo(w2.x), bfhi(w.x) + bfhi(w2.x), bflo(w.y) + bflo(w2.y), bfhi(w.y) + bfhi(w2.y)}; }
            else if (DBG_STOP == 2) { const size_t r = i / 256, c4 = i % 256; const bf16* src = (c4 < 128) ? F.Cb + r * 512 + c4 * 4 : F.AO + r * 512 + (c4 - 128) * 4; const v2u w = *(const GAS v2u*)src; v = (f32x4){bflo(w.x), bfhi(w.x), bflo(w.y), bfhi(w.y)}; }
            else if (DBG_STOP == 1) { const v2u w = ((const GAS v2u*)F.Gt)[i]; v = (f32x4){bflo(w.x), bfhi(w.x), bflo(w.y), bfhi(w.y)}; }
            else if (DBG_STOP == 5) { const v2u w = ((const GAS v2u*)F.XB)[i]; v = (f32x4){bflo(w.x), bfhi(w.x), bflo(w.y), bfhi(w.y)}; }
            else if (DBG_STOP == 6) v = ((const GAS f32x4*)F.ST)[i] + ((const GAS f32x4*)F.ST)[i + n4];
            else if (DBG_STOP == 7) { if (i < (size_t)T * 32) { const v4u w = ((const GAS v4u*)F.IDX)[i]; v = (f32x4){(float)w.x, (float)w.y, (float)w.z, (float)w.w}; } else if (i < (size_t)T * 64) v = ((const GAS f32x4*)F.GATE)[i - (size_t)T * 32]; }
            ((GAS f32x4*)F.out)[i] = v; }
    }
#endif
#undef IN
#undef BOTH
}

extern "C" void kernel_launch(void* const* d_in, const int* in_sizes, int n_in, void* d_out, int out_size, void* d_ws, size_t ws_size, hipStream_t stream) {
    static int grid = 0;
    if (grid == 0) {
        if (n_in != 21 || in_sizes[0] != T * D || out_size != T * D || ws_size < WS_END) { fprintf(stderr, "kernel_launch: unexpected shapes (n_in %d, in0 %d, out %d, ws %zu); nothing launched\n", n_in, n_in > 0 ? in_sizes[0] : -1, out_size, ws_size); grid = -1; return; }
        int dev = 0, cus = 0, per_cu = 0;
        if (hipGetDevice(&dev) != hipSuccess || hipDeviceGetAttribute(&cus, hipDeviceAttributeMultiprocessorCount, dev) != hipSuccess) { grid = -1; return; }
        if (hipFuncSetAttribute((const void*)fwd_kernel, hipFuncAttributeMaxDynamicSharedMemorySize, LDS_BYTES) != hipSuccess) { fprintf(stderr, "kernel_launch: hipFuncSetAttribute failed\n"); grid = -1; return; }
        if (hipOccupancyMaxActiveBlocksPerMultiprocessor(&per_cu, (const void*)fwd_kernel, NWAVES * 64, LDS_BYTES) != hipSuccess || per_cu < 1)
            fprintf(stderr, "kernel_launch: note: occupancy query reports %d workgroups per CU\n", per_cu);
        (void)hipGetLastError();
        grid = cus;
    }
    if (grid < 0) return;
    if (hipMemsetAsync((char*)d_ws + WS_CTL, 0, CTL_ZERO_BYTES, stream) != hipSuccess) return;
    Args a{};
    for (int i = 0; i < 21; ++i) a.in[i] = (const float*)d_in[i];
    a.out = (float*)d_out; a.ws = (unsigned char*)d_ws;
    for (int li = 0; li < MK_N_LAUNCHES; ++li) {
        a.ph_lo = (MK_N_LAUNCHES == 1) ? 0 : li; a.ph_hi = (MK_N_LAUNCHES == 1) ? N_PHASES : li + 1; a.li = li;
        hipLaunchKernelGGL(fwd_kernel, dim3(grid), dim3(NWAVES * 64), LDS_BYTES, stream, a);
    }
}
```

```cpp
#include <hip/hip_runtime.h>
#include <hip/hip_bf16.h>
#include <cstdio>
#include <cstdint>
#include <cmath>

#ifndef MK_N_LAUNCHES
#define MK_N_LAUNCHES 1
#endif

namespace pg8 {
#define PG8_LAS __attribute__((address_space(3)))
typedef unsigned short bf16_t;
typedef short bf16x8 __attribute__((ext_vector_type(8)));
typedef float f32x4 __attribute__((ext_vector_type(4)));
typedef unsigned u32x4 __attribute__((ext_vector_type(4)));
constexpr int BM = 256, BK = 64, HALF = 128, HTB = HALF * BK * 2, STAGE_BYTES = 8 * HTB, NXCD = 8, WGM = 8;

__host__ __device__ __forceinline__ int lds_byte(int r, int c) { const int st = (r >> 4) * 2 + (c >> 5), rr = r & 15, cc = c & 31, ob = rr * 64 + cc * 2; return st * 1024 + (ob ^ (((ob >> 9) & 1) << 5)); }
__host__ __device__ __forceinline__ void stage_rc(int b, int& R, int& C) { const int st = b / 1024, sb = b % 1024, swz = sb ^ (((sb >> 9) & 1) << 5); R = (st >> 1) * 16 + swz / 64; C = (st & 1) * 32 + (swz % 64) / 2; }
__host__ __device__ __forceinline__ int perm32(int rho) { const int n = rho >> 4, i = rho & 15; return 8 * (i >> 2) + 4 * n + (i & 3); }

struct Unit { int pm, pn; };
struct Gemm { const bf16_t* A; const bf16_t* Bt; int M, N, K, lda, ldb; };

struct StaticOrder {
    int nM, nN, nwg, G, c;
    __host__ __device__ void init(int M, int N, int G_, int c_) { nM = M / BM; nN = N / BM; nwg = nM * nN; G = G_; c = c_; }
    __host__ __device__ bool next(int i, Unit& u) const {
        const long L = (long)i * G + c; if (L >= nwg) return false;
        int wgid = (int)L; { const int q = nwg / NXCD, r = nwg % NXCD, xcd = wgid % NXCD, off = wgid / NXCD; wgid = (xcd < r ? xcd * (q + 1) : r * (q + 1) + (xcd - r) * q) + off; }
        const int nig = WGM * nN, gid = wgid / nig, fm = gid * WGM, gsz = (nM - fm) < WGM ? (nM - fm) : WGM;
        u.pm = fm + ((wgid % nig) % gsz); u.pn = (wgid % nig) / gsz; return true;
    }
    __device__ __forceinline__ void a_ready(const Unit&) const {}
    __device__ __forceinline__ void done(const Unit&) const {}
};

__device__ __forceinline__ unsigned cvt_pk_bf16(float lo, float hi) { typedef float f2_t __attribute__((ext_vector_type(2))); typedef __bf16 b2_t __attribute__((ext_vector_type(2))); f2_t v = {lo, hi}; b2_t b = __builtin_convertvector(v, b2_t); return __builtin_bit_cast(unsigned, b); }
__device__ __forceinline__ float sigmoid_f(float x) { return __builtin_amdgcn_rcpf(1.0f + __builtin_amdgcn_exp2f(-1.4426950408889634f * x)); }

struct EpiF32 {
    static constexpr bool PERM = false, AFTER_DRAIN = false;
    float* C; int ldc;
    __device__ __forceinline__ void operator()(const f32x4 (&acc)[2][2][4][2], const Unit& u, int wr, int wc, int fr, int fq) const {
        const int row0 = u.pm * BM + wr * 64 + fr, col0 = u.pn * BM + wc * 32 + 4 * fq;
#pragma unroll
        for (int ai = 0; ai < 2; ++ai)
#pragma unroll
            for (int m = 0; m < 4; ++m) { float* rowp = C + (size_t)(row0 + ai * HALF + m * 16) * ldc + col0;
#pragma unroll
                for (int bj = 0; bj < 2; ++bj)
#pragma unroll
                    for (int n = 0; n < 2; ++n) *(f32x4*)(rowp + bj * HALF + n * 16) = acc[ai][bj][m][n]; }
    }
};
struct EpiRes {
    static constexpr bool PERM = false, AFTER_DRAIN = false;
    float* C; const float* X; const float* bias; float alpha; int ldc;
    __device__ __forceinline__ void operator()(const f32x4 (&acc)[2][2][4][2], const Unit& u, int wr, int wc, int fr, int fq) const {
        const int row0 = u.pm * BM + wr * 64 + fr, col0 = u.pn * BM + wc * 32 + 4 * fq;
        f32x4 bv[2][2];
#pragma unroll
        for (int bj = 0; bj < 2; ++bj)
#pragma unroll
            for (int n = 0; n < 2; ++n) bv[bj][n] = *(const f32x4*)(bias + col0 + bj * HALF + n * 16);
#pragma unroll
        for (int ai = 0; ai < 2; ++ai)
#pragma unroll
            for (int m = 0; m < 4; ++m) { const size_t off = (size_t)(row0 + ai * HALF + m * 16) * ldc + col0;
#pragma unroll
                for (int bj = 0; bj < 2; ++bj)
#pragma unroll
                    for (int n = 0; n < 2; ++n) { const f32x4 xv = *(const f32x4*)(X + off + bj * HALF + n * 16);
                        *(f32x4*)(C + off + bj * HALF + n * 16) = acc[ai][bj][m][n] + bv[bj][n] + xv * alpha; } }
    }
};
struct EpiIn {
    static constexpr bool PERM = true, AFTER_DRAIN = false;
    const float* b_in; bf16_t* GLU; bf16_t* Q; bf16_t* Kb; bf16_t* G; float qscale;
    __device__ __forceinline__ void operator()(const f32x4 (&acc)[2][2][4][2], const Unit& u, int wr, int wc, int fr, int fq) const {
        const int row0 = u.pm * BM + wr * 64 + fr; const int cw = wc * 32 + 8 * fq;
        if (u.pn < 4) {
            const int oc = u.pn * 128 + cw;
            const f32x4 ba0 = *(const f32x4*)(b_in + oc), ba1 = *(const f32x4*)(b_in + oc + 4), bg0 = *(const f32x4*)(b_in + 512 + oc), bg1 = *(const f32x4*)(b_in + 512 + oc + 4);
#pragma unroll
            for (int ai = 0; ai < 2; ++ai)
#pragma unroll
                for (int m = 0; m < 4; ++m) { const size_t row = (size_t)(row0 + ai * HALF + m * 16);
                    const f32x4 a0 = acc[ai][0][m][0] + ba0, a1 = acc[ai][0][m][1] + ba1, g0 = acc[ai][1][m][0] + bg0, g1 = acc[ai][1][m][1] + bg1;
                    u32x4 w;
                    w.x = cvt_pk_bf16(a0[0] * sigmoid_f(g0[0]), a0[1] * sigmoid_f(g0[1])); w.y = cvt_pk_bf16(a0[2] * sigmoid_f(g0[2]), a0[3] * sigmoid_f(g0[3]));
                    w.z = cvt_pk_bf16(a1[0] * sigmoid_f(g1[0]), a1[1] * sigmoid_f(g1[1])); w.w = cvt_pk_bf16(a1[2] * sigmoid_f(g1[2]), a1[3] * sigmoid_f(g1[3]));
                    *(u32x4*)(GLU + row * 512 + oc) = w; }
        } else if (u.pn < 8) {
            const int which = (u.pn - 4) >> 1; bf16_t* base = which ? Kb : Q; const float sc = which ? 1.0f : qscale;
#pragma unroll
            for (int bj = 0; bj < 2; ++bj) { const int cwithin = ((u.pn - 4) & 1) * 256 + bj * HALF + cw; const int ocol = 1024 + which * 512 + cwithin;
                const f32x4 b0 = *(const f32x4*)(b_in + ocol), b1 = *(const f32x4*)(b_in + ocol + 4);
#pragma unroll
                for (int ai = 0; ai < 2; ++ai)
#pragma unroll
                    for (int m = 0; m < 4; ++m) { const size_t row = (size_t)(row0 + ai * HALF + m * 16);
                        const f32x4 v0 = (acc[ai][bj][m][0] + b0) * sc, v1 = (acc[ai][bj][m][1] + b1) * sc;
                        u32x4 w; w.x = cvt_pk_bf16(v0[0], v0[1]); w.y = cvt_pk_bf16(v0[2], v0[3]); w.z = cvt_pk_bf16(v1[0], v1[1]); w.w = cvt_pk_bf16(v1[2], v1[3]);
                        *(u32x4*)(base + row * 512 + cwithin) = w; } }
        } else {
#pragma unroll
            for (int bj = 0; bj < 2; ++bj) { const int gcol = (u.pn - 8) * 256 + bj * HALF + cw; const int ocol = 2560 + gcol;
                const f32x4 b0 = *(const f32x4*)(b_in + ocol), b1 = *(const f32x4*)(b_in + ocol + 4);
#pragma unroll
                for (int ai = 0; ai < 2; ++ai)
#pragma unroll
                    for (int m = 0; m < 4; ++m) { const size_t row = (size_t)(row0 + ai * HALF + m * 16);
                        const f32x4 v0 = acc[ai][bj][m][0] + b0, v1 = acc[ai][bj][m][1] + b1;
#ifdef DBG_NOSIG
                        u32x4 w; w.x = cvt_pk_bf16(v0[0], v0[1]); w.y = cvt_pk_bf16(v0[2], v0[3]); w.z = cvt_pk_bf16(v1[0], v1[1]); w.w = cvt_pk_bf16(v1[2], v1[3]);
#else
                        u32x4 w; w.x = cvt_pk_bf16(sigmoid_f(v0[0]), sigmoid_f(v0[1])); w.y = cvt_pk_bf16(sigmoid_f(v0[2]), sigmoid_f(v0[3]));
                        w.z = cvt_pk_bf16(sigmoid_f(v1[0]), sigmoid_f(v1[1])); w.w = cvt_pk_bf16(sigmoid_f(v1[2]), sigmoid_f(v1[3]));
#endif
                        *(u32x4*)(G + row * 2048 + gcol) = w; } }
        }
    }
};
struct EpiVT {
    static constexpr bool PERM = true, AFTER_DRAIN = false;
    const float* rbias; bf16_t* O; int ldc;
    __device__ __forceinline__ void operator()(const f32x4 (&acc)[2][2][4][2], const Unit& u, int wr, int wc, int fr, int fq) const {
        const int row0 = u.pm * BM + wr * 64 + fr; const int col0 = u.pn * BM + wc * 32 + 8 * fq;
#pragma unroll
        for (int ai = 0; ai < 2; ++ai)
#pragma unroll
            for (int m = 0; m < 4; ++m) { const int row = row0 + ai * HALF + m * 16; const float rb = rbias[row];
#pragma unroll
                for (int bj = 0; bj < 2; ++bj) { const f32x4 v0 = acc[ai][bj][m][0] + rb, v1 = acc[ai][bj][m][1] + rb;
                    u32x4 w; w.x = cvt_pk_bf16(v0[0], v0[1]); w.y = cvt_pk_bf16(v0[2], v0[3]); w.z = cvt_pk_bf16(v1[0], v1[1]); w.w = cvt_pk_bf16(v1[2], v1[3]);
                    *(u32x4*)(O + (size_t)row * ldc + col0 + bj * HALF) = w; } }
    }
};
struct EpiGate {
    static constexpr bool PERM = true, AFTER_DRAIN = false;
    const float* bias; const bf16_t* Gt; bf16_t* O; int gcol0, ocol0;
    __device__ __forceinline__ void operator()(const f32x4 (&acc)[2][2][4][2], const Unit& u, int wr, int wc, int fr, int fq) const {
        const int row0 = u.pm * BM + wr * 64 + fr; const int col0 = u.pn * BM + wc * 32 + 8 * fq;
#pragma unroll
        for (int bj = 0; bj < 2; ++bj) { const int c = col0 + bj * HALF;
            f32x4 b0 = (f32x4){0.f, 0.f, 0.f, 0.f}, b1 = b0; if (bias) { b0 = *(const f32x4*)(bias + c); b1 = *(const f32x4*)(bias + c + 4); }
#pragma unroll
            for (int ai = 0; ai < 2; ++ai)
#pragma unroll
                for (int m = 0; m < 4; ++m) { const size_t row = (size_t)(row0 + ai * HALF + m * 16);
                    const u32x4 gw = *(const u32x4*)(Gt + row * 2048 + gcol0 + c);
                    const f32x4 v0 = acc[ai][bj][m][0] + b0, v1 = acc[ai][bj][m][1] + b1;
                    u32x4 w;
                    w.x = cvt_pk_bf16(v0[0] * __uint_as_float(gw.x << 16), v0[1] * __uint_as_float(gw.x & 0xffff0000u));
                    w.y = cvt_pk_bf16(v0[2] * __uint_as_float(gw.y << 16), v0[3] * __uint_as_float(gw.y & 0xffff0000u));
                    w.z = cvt_pk_bf16(v1[0] * __uint_as_float(gw.z << 16), v1[1] * __uint_as_float(gw.z & 0xffff0000u));
                    w.w = cvt_pk_bf16(v1[2] * __uint_as_float(gw.w << 16), v1[3] * __uint_as_float(gw.w & 0xffff0000u));
                    *(u32x4*)(O + row * 2048 + ocol0 + c) = w; } }
    }
};

template <class Epi, class Sched, bool ALIGN_EPI = false, bool SP2 = false>
__device__ __forceinline__ void gemm_phase(PG8_LAS unsigned char* lds, const Gemm g, const Sched& S, const Epi& E) {
    const int tid = threadIdx.x, wid = __builtin_amdgcn_readfirstlane(tid >> 6), lane = tid & 63, wr = wid >> 2, wc = wid & 3, fr = lane & 15, fq = lane >> 4;
    const int K = g.K, nt = K / BK;
    unsigned voffA[2], voffB[2];
#pragma unroll
    for (int i = 0; i < 2; ++i) { int R, C; stage_rc(tid * 16 + i * 8192, R, C); const int Rb = Epi::PERM ? ((R & ~31) + perm32(R & 31)) : R;
        voffA[i] = (unsigned)(R * g.lda + C) * 2u; voffB[i] = (unsigned)(Rb * g.ldb + C) * 2u; }
    const size_t kstep = (size_t)(BK * 2);
    const size_t hstepA = (size_t)HALF * g.lda * 2, hstepB = (size_t)HALF * g.ldb * 2;
    const size_t tstepA = 2 * hstepA, tstepB = 2 * hstepB;
    const unsigned ldsw = (unsigned)wid * 1024u;
    const int aoff = lds_byte(wr * 64 + fr, fq * 8), boff = lds_byte(wc * 32 + fr, fq * 8);
#define PG8_SA(b, h) (((b) * 2 + (h)) * HTB)
#define PG8_SB(b, h) ((4 + (b) * 2 + (h)) * HTB)
#define PG8_STAGE(bufoff, gbase, voff) do { _Pragma("unroll") for (int _i = 0; _i < 2; ++_i) \
        __builtin_amdgcn_global_load_lds((const unsigned*)((const char*)(gbase) + (voff)[_i]), (PG8_LAS unsigned*)(lds + (bufoff) + ldsw + _i * 8192), 16, 0, 0); } while (0)
#define PG8_LDA(dst, b, h) do { _Pragma("unroll") for (int m = 0; m < 4; ++m) _Pragma("unroll") for (int k = 0; k < 2; ++k) dst[m][k] = *(const PG8_LAS bf16x8*)(lds + PG8_SA(b, h) + aoff + m * 2048 + k * 1024); } while (0)
#define PG8_LDB(dst, b, h) do { _Pragma("unroll") for (int n = 0; n < 2; ++n) _Pragma("unroll") for (int k = 0; k < 2; ++k) dst[n][k] = *(const PG8_LAS bf16x8*)(lds + PG8_SB(b, h) + boff + n * 2048 + k * 1024); } while (0)
#define PG8_MMA(ai, bj, At, Bt) do { __builtin_amdgcn_s_setprio(1); _Pragma("unroll") for (int m = 0; m < 4; ++m) _Pragma("unroll") for (int n = 0; n < 2; ++n) _Pragma("unroll") for (int k = 0; k < 2; ++k) \
        acc[ai][bj][m][n] = __builtin_amdgcn_mfma_f32_16x16x32_bf16(Bt[n][k], At[m][k], acc[ai][bj][m][n], 0, 0, 0); __builtin_amdgcn_s_setprio(0); } while (0)
#define PG8_WAIT_V(n) asm volatile("s_waitcnt vmcnt(" #n ")" ::: "memory")
#define PG8_WAIT_L(n) asm volatile("s_waitcnt lgkmcnt(" #n ")" ::: "memory")
#define PG8_BAR __builtin_amdgcn_s_barrier()
#define PG8_SCHED __builtin_amdgcn_sched_barrier(0)
    Unit cur, nxt; int ui = 0;
    if (!S.next(0, cur)) return;
    f32x4 acc[2][2][4][2];
#pragma unroll
    for (int a = 0; a < 2; ++a)
#pragma unroll
        for (int b = 0; b < 2; ++b)
#pragma unroll
            for (int m = 0; m < 4; ++m)
#pragma unroll
                for (int n = 0; n < 2; ++n) acc[a][b][m][n] = (f32x4){0.f, 0.f, 0.f, 0.f};
    bf16x8 At[4][2], B0[2][2], B1[2][2];
    const char* cA = (const char*)g.A + (size_t)cur.pm * tstepA; const char* cB = (const char*)g.Bt + (size_t)cur.pn * tstepB;
    S.a_ready(cur);
    if constexpr (SP2) {
        PG8_STAGE(PG8_SB(0, 0), cB, voffB); PG8_STAGE(PG8_SB(0, 1), cB + hstepB, voffB); PG8_STAGE(PG8_SA(0, 0), cA, voffA); PG8_STAGE(PG8_SA(0, 1), cA + hstepA, voffA);
        if (wr == 1) PG8_BAR;
        PG8_WAIT_V(2); PG8_BAR;
        PG8_STAGE(PG8_SB(1, 0), cB + kstep, voffB); PG8_STAGE(PG8_SA(1, 0), cA + kstep, voffA); PG8_STAGE(PG8_SB(1, 1), cB + hstepB + kstep, voffB);
        PG8_WAIT_V(6); PG8_BAR;
    } else {
        PG8_STAGE(PG8_SB(0, 0), cB, voffB); PG8_STAGE(PG8_SA(0, 0), cA, voffA); PG8_STAGE(PG8_SB(0, 1), cB + hstepB, voffB); PG8_STAGE(PG8_SA(0, 1), cA + hstepA, voffA);
        if (wr == 1) PG8_BAR;
        PG8_WAIT_V(4); PG8_BAR;
        PG8_STAGE(PG8_SB(1, 0), cB + kstep, voffB); PG8_STAGE(PG8_SA(1, 0), cA + kstep, voffA); PG8_STAGE(PG8_SB(1, 1), cB + hstepB + kstep, voffB);
        PG8_WAIT_V(6); PG8_BAR;
    }
    for (;;) {
        const bool has_next = S.next(ui + 1, nxt);
        const char* nA = has_next ? (const char*)g.A + (size_t)nxt.pm * tstepA : cA; const char* nB = has_next ? (const char*)g.Bt + (size_t)nxt.pn * tstepB : cB;
        for (int t = 0; t < nt; t += 2) {
            const bool last = (t == nt - 2);
            const char* a1 = cA + (size_t)(t + 1) * kstep;
            const char* a2 = last ? nA : cA + (size_t)(t + 2) * kstep; const char* b2 = last ? nB : cB + (size_t)(t + 2) * kstep;
            const char* a3 = a2 + kstep; const char* b3 = b2 + kstep;
            if (last && has_next) S.a_ready(nxt);
            if constexpr (SP2) {
            PG8_LDB(B0, 0, 0); PG8_LDB(B1, 0, 1); PG8_SCHED; PG8_LDA(At, 0, 0); PG8_STAGE(PG8_SA(1, 1), a1 + hstepA, voffA);
            PG8_WAIT_V(8); PG8_WAIT_L(0); PG8_BAR; PG8_MMA(0, 0, At, B0); PG8_MMA(0, 1, At, B1); PG8_BAR; PG8_SCHED;
            PG8_LDA(At, 0, 1); PG8_STAGE(PG8_SB(0, 0), b2, voffB); PG8_STAGE(PG8_SB(0, 1), b2 + hstepB, voffB); PG8_STAGE(PG8_SA(0, 0), a2, voffA);
            PG8_WAIT_V(8); PG8_WAIT_L(0); PG8_BAR; PG8_MMA(1, 0, At, B0); PG8_MMA(1, 1, At, B1); PG8_BAR; PG8_SCHED;
            PG8_LDB(B0, 1, 0); PG8_LDB(B1, 1, 1); PG8_SCHED; PG8_LDA(At, 1, 0); PG8_STAGE(PG8_SA(0, 1), a2 + hstepA, voffA);
            PG8_WAIT_V(8); PG8_WAIT_L(0); PG8_BAR; PG8_MMA(0, 0, At, B0); PG8_MMA(0, 1, At, B1); PG8_BAR; PG8_SCHED;
            PG8_LDA(At, 1, 1); PG8_STAGE(PG8_SB(1, 0), b3, voffB); PG8_STAGE(PG8_SB(1, 1), b3 + hstepB, voffB); PG8_STAGE(PG8_SA(1, 0), a3, voffA);
            PG8_WAIT_V(8); PG8_WAIT_L(0); PG8_BAR; PG8_MMA(1, 0, At, B0); PG8_MMA(1, 1, At, B1); PG8_BAR; PG8_SCHED;
            } else {
            PG8_LDB(B0, 0, 0); PG8_SCHED; PG8_LDA(At, 0, 0); PG8_STAGE(PG8_SA(1, 1), a1 + hstepA, voffA);
            PG8_WAIT_L(8); PG8_BAR; PG8_WAIT_L(0); PG8_MMA(0, 0, At, B0); PG8_BAR; PG8_SCHED;
            PG8_LDB(B1, 0, 1); PG8_STAGE(PG8_SB(0, 0), b2, voffB);
            PG8_BAR; PG8_WAIT_L(0); PG8_MMA(0, 1, At, B1); PG8_BAR;
            PG8_LDA(At, 0, 1); PG8_STAGE(PG8_SA(0, 0), a2, voffA);
            PG8_BAR; PG8_WAIT_L(0); PG8_MMA(1, 0, At, B0); PG8_BAR; PG8_SCHED;
            PG8_STAGE(PG8_SB(0, 1), b2 + hstepB, voffB);
            PG8_WAIT_V(6); PG8_BAR; PG8_MMA(1, 1, At, B1); PG8_BAR;
            PG8_LDB(B0, 1, 0); PG8_SCHED; PG8_LDA(At, 1, 0); PG8_STAGE(PG8_SA(0, 1), a2 + hstepA, voffA);
            PG8_WAIT_L(8); PG8_BAR; PG8_WAIT_L(0); PG8_MMA(0, 0, At, B0); PG8_BAR; PG8_SCHED;
            PG8_LDB(B1, 1, 1); PG8_STAGE(PG8_SB(1, 0), b3, voffB);
            PG8_BAR; PG8_WAIT_L(0); PG8_MMA(0, 1, At, B1); PG8_BAR;
            PG8_LDA(At, 1, 1); PG8_STAGE(PG8_SA(1, 0), a3, voffA);
            PG8_BAR; PG8_WAIT_L(0); PG8_MMA(1, 0, At, B0); PG8_BAR; PG8_SCHED;
            PG8_STAGE(PG8_SB(1, 1), b3 + hstepB, voffB);
            PG8_WAIT_V(6); PG8_BAR; PG8_MMA(1, 1, At, B1); PG8_BAR;
            }
        }
        if constexpr (ALIGN_EPI) { if (wr == 0) PG8_BAR; }
        if constexpr (!Epi::AFTER_DRAIN) { E(acc, cur, wr, wc, fr, fq); S.done(cur); }
        if (!has_next) break;
#pragma unroll
        for (int a = 0; a < 2; ++a)
#pragma unroll
            for (int b = 0; b < 2; ++b)
#pragma unroll
                for (int m = 0; m < 4; ++m)
#pragma unroll
                    for (int n = 0; n < 2; ++n) acc[a][b][m][n] = (f32x4){0.f, 0.f, 0.f, 0.f};
        cur = nxt; cA = nA; cB = nB; ++ui;
        if constexpr (ALIGN_EPI) { if (wr == 1) PG8_BAR; }
    }
    PG8_WAIT_V(0);
    if constexpr (!ALIGN_EPI) { if (wr == 0) PG8_BAR; }
    PG8_BAR;
#undef PG8_SA
#undef PG8_SB
#undef PG8_STAGE
#undef PG8_LDA
#undef PG8_LDB
#undef PG8_MMA
#undef PG8_WAIT_V
#undef PG8_WAIT_L
#undef PG8_BAR
#undef PG8_SCHED
}
}

constexpr int NWAVES = 8;
constexpr int BATCH = 8, SEQ = 4096, D = 1024, T = BATCH * SEQ;
constexpr int CONVD = 512, CONVW = 31, SBH = 8, SBD = 64, SBDIM = 512;
constexpr int PH = 8, NKEYS = 128, TOPK = 16, NEXP = NKEYS * NKEYS;
constexpr int NIN = 4096;
constexpr float LN_EPS = 1e-5f;
constexpr float ALPHA = 1.189207115002721f;
constexpr float QSCALE = 0.125f * 1.4426950408889634f;
constexpr int N_PHASES = 9;

constexpr size_t MiB = 1u << 20;
constexpr size_t WS_CTL = 0, CTL_ZERO_BYTES = 1 * MiB;
constexpr size_t WS_WIN = 2 * MiB;
constexpr size_t WS_WV = 10 * MiB;
constexpr size_t WS_WPW2 = 11 * MiB;
constexpr size_t WS_WO = 12 * MiB;
constexpr size_t WS_WOUT = 13 * MiB;
constexpr size_t WS_WEFF = 17 * MiB;
constexpr size_t WS_IDX = 21 * MiB;
constexpr size_t WS_GATE = 37 * MiB;
constexpr size_t WS_UT = 53 * MiB;
constexpr size_t WS_VTAB = 85 * MiB;
constexpr size_t WS_USC = 70 * MiB;
constexpr size_t WS_VSC = 102 * MiB;
constexpr size_t WS_XB = 117 * MiB;
constexpr size_t WS_C = 181 * MiB;
constexpr size_t WS_AO = 213 * MiB;
constexpr size_t WS_GLU = 373 * MiB;
constexpr size_t WS_Q = 405 * MiB;
constexpr size_t WS_K = 437 * MiB;
constexpr size_t WS_VT = 469 * MiB;
constexpr size_t WS_M2 = 373 * MiB;
constexpr size_t WS_G = 245 * MiB;
constexpr size_t WS_R = 245 * MiB;
constexpr size_t WS_ST = 245 * MiB;
constexpr size_t WS_END = 501 * MiB;
constexpr int CW_BAR = 4096;

constexpr int RING_OFF = 0, RING_BYTES = 131072;
constexpr int LDSCTL_OFF = RING_BYTES, MISC_OFF = LDSCTL_OFF + 320;
constexpr int LDS_BYTES = 147456;

#define GAS __attribute__((address_space(1)))
#define LAS __attribute__((address_space(3)))
typedef unsigned short bf16;
typedef unsigned v4u __attribute__((ext_vector_type(4)));
typedef unsigned v2u __attribute__((ext_vector_type(2)));
typedef float f32x4 __attribute__((ext_vector_type(4)));
typedef float f32x16 __attribute__((ext_vector_type(16)));
typedef float f32x2 __attribute__((ext_vector_type(2)));
typedef short bf16x8 __attribute__((ext_vector_type(8)));
typedef GAS unsigned gu32;
#define RLX_AGENT __ATOMIC_RELAXED, __HIP_MEMORY_SCOPE_AGENT
#define LDS_WAIT() asm volatile("s_waitcnt lgkmcnt(0)" ::: "memory")
#define VM_WAIT() asm volatile("s_waitcnt vmcnt(0)" ::: "memory")
__device__ __forceinline__ unsigned f2bf(float f) { unsigned u = __builtin_bit_cast(unsigned, f); return (u + 0x7fffu + ((u >> 16) & 1u)) >> 16; }
__device__ __forceinline__ unsigned pk2(float lo, float hi) { return f2bf(lo) | (f2bf(hi) << 16); }
__device__ __forceinline__ float bflo(unsigned w) { return __uint_as_float(w << 16); }
__device__ __forceinline__ float bfhi(unsigned w) { return __uint_as_float(w & 0xffff0000u); }

#define XB_TMO      128
#define XB_XCNT(j)  (256  + 64 * (j))
#define XB_XSUB(j)  (1280 + 64 * (j))
#define XB_XGEN(j)  (2304 + 64 * (j))
#define XB_TOP      3328
#define XB_TOPGEN   3392
#define XCD_BAR_WORDS 3456
#define XB_SPIN_CAP (1u << 18)
__device__ __forceinline__ unsigned xb_ld(unsigned* p)              { return __hip_atomic_load(p, __ATOMIC_RELAXED, __HIP_MEMORY_SCOPE_AGENT); }
__device__ __forceinline__ unsigned xb_add(unsigned* p, unsigned v) { return __hip_atomic_fetch_add(p, v, __ATOMIC_RELAXED, __HIP_MEMORY_SCOPE_AGENT); }
__device__ __forceinline__ unsigned xb_xcc_id() { return (unsigned)__builtin_amdgcn_s_getreg((3 << 11) | 20) & 0xFu; }
#define XB_SPIN(cond, bar) do { unsigned _sp = 0; while (cond) { __builtin_amdgcn_s_sleep(1); \
    if ((++_sp & 255u) == 0u) { if (xb_ld(&(bar)[XB_TMO])) break; if (_sp > XB_SPIN_CAP) { atomicAdd(&(bar)[XB_TMO], 1u); break; } } } } while (0)
struct XcdBarrier { unsigned* bar; unsigned x; volatile LAS unsigned* st; };
__device__ __forceinline__ XcdBarrier xcd_barrier_post(unsigned* bar, volatile LAS unsigned* st) {
    XcdBarrier b; b.bar = bar; b.x = xb_xcc_id(); b.st = st;
    if (threadIdx.x == 0) (void)xb_add(&bar[XB_XCNT(b.x)], 1u);
    return b;
}
__device__ __forceinline__ void xcd_barrier_complete(unsigned* bar, unsigned x, unsigned& nloc, unsigned& nx) {
    const unsigned G = gridDim.x * gridDim.y * gridDim.z;
    unsigned sum, cnt, mine, sp = 0u;
    for (;;) {
        sum = 0u; cnt = 0u; mine = 0u;
#pragma unroll
        for (unsigned j = 0; j < 16; ++j) { const unsigned c = xb_ld(&bar[XB_XCNT(j)]); sum += c; cnt += (c > 0u) ? 1u : 0u; mine = (j == x) ? c : mine; }
        if (sum == G) break;
        __builtin_amdgcn_s_sleep(1);
        if ((++sp & 255u) == 0u) { if (xb_ld(&bar[XB_TMO])) break; if (sp > XB_SPIN_CAP) { atomicAdd(&bar[XB_TMO], 1u); break; } }
    }
    nloc = mine > 0u ? mine : 1u; nx = cnt > 0u ? cnt : 1u;
}
__device__ __forceinline__ void xcd_barrier(const XcdBarrier& b) {
    asm volatile("s_waitcnt vmcnt(0)" ::: "memory");
    __syncthreads();
    if (threadIdx.x == 0) {
        unsigned* bar = b.bar;
        __builtin_amdgcn_s_waitcnt(0);
        unsigned nloc = b.st[0], nx = b.st[1];
        if (nloc == 0u) { xcd_barrier_complete(bar, b.x, nloc, nx); b.st[0] = nloc; b.st[1] = nx; }
        const unsigned old = xb_add(&bar[XB_XSUB(b.x)], 1u);
        const unsigned gen = old / nloc;
        if (old + 1u == (gen + 1u) * nloc) {
            __builtin_amdgcn_fence(__ATOMIC_RELEASE, "agent");
            asm volatile("s_waitcnt vmcnt(0)" ::: "memory");
            const unsigned og = xb_add(&bar[XB_TOP], 1u);
            const unsigned tg = og / nx;
            if (og + 1u == (tg + 1u) * nx) xb_add(&bar[XB_TOPGEN], 1u);
            else XB_SPIN(xb_ld(&bar[XB_TOPGEN]) == tg, bar);
            __builtin_amdgcn_fence(__ATOMIC_ACQUIRE, "agent");
            xb_add(&bar[XB_XGEN(b.x)], 1u);
            asm volatile("s_waitcnt vmcnt(0)" ::: "memory");
        } else {
            XB_SPIN(xb_ld(&bar[XB_XGEN(b.x)]) == gen, bar);
            __builtin_amdgcn_fence(__ATOMIC_ACQUIRE, "agent");
            asm volatile("s_waitcnt vmcnt(0)" ::: "memory");
        }
    }
    __syncthreads();
}

struct Frame {
    LAS unsigned char* lds;
    volatile LAS unsigned* MISC;
    gu32* ctl;
    int tid, lane, wave;
    int vcu, G;
    const float *x, *w_in, *b_in, *cw_dw, *cb_dw, *cln_g, *cln_b, *w_pw2, *b_pw2, *w_o, *w_out, *b_out, *ln1_g, *ln1_b, *w_q, *keys1, *keys2, *pu, *pv, *ln2_g, *ln2_b;
    float* out;
    unsigned char *UT, *VTAB; float *USC, *VSC;
    bf16 *WinT, *WvT, *Wpw2T, *WoT, *WoutT, *WeffT, *XB, *Cb, *AO, *GLU, *Qb, *Kb, *VT, *M2, *Gt;
    float *R, *ST, *GATE; int* IDX;
};

__device__ __forceinline__ float wave_sum(float v) {
#pragma unroll
    for (int o = 1; o < 64; o <<= 1) v += __shfl_xor(v, o);
    return v;
}

__device__ __forceinline__ void p0_transpose_item(const float* W, int ldw, int src_col0, int k0, bf16* WT, int ldt, int dst_row0, int dst_k0, LAS float* scr, int lane) {
#pragma unroll 8
    for (int i = 0; i < 32; ++i) { const int kk = 2 * i + (lane >> 5); scr[kk * 33 + (lane & 31)] = W[(size_t)(k0 + kk) * ldw + src_col0 + (lane & 31)]; }
    LDS_WAIT(); asm volatile("" ::: "memory");
    const int c = lane & 7;
#pragma unroll
    for (int j = 0; j < 4; ++j) { const int n = (lane >> 3) + 8 * j; const LAS float* s = scr + (8 * c) * 33 + n;
        v4u o; o.x = pk2(s[0 * 33], s[1 * 33]); o.y = pk2(s[2 * 33], s[3 * 33]); o.z = pk2(s[4 * 33], s[5 * 33]); o.w = pk2(s[6 * 33], s[7 * 33]);
        *(GAS v4u*)(WT + (size_t)(dst_row0 + n) * ldt + dst_k0 + 8 * c) = o; }
    LDS_WAIT(); asm volatile("" ::: "memory");
}
__device__ __forceinline__ void p0_convert(const float* src, bf16* dst, size_t n8, int gw, int NGW, int lane) {
    for (size_t i = (size_t)gw * 64 + lane; i < n8; i += (size_t)NGW * 64) {
        const f32x4 a = *(const GAS f32x4*)(src + i * 8), b = *(const GAS f32x4*)(src + i * 8 + 4);
        v4u o; o.x = pk2(a.x, a.y); o.y = pk2(a.z, a.w); o.z = pk2(b.x, b.y); o.w = pk2(b.z, b.w);
        *(GAS v4u*)(dst + i * 8) = o; }
}
__device__ __forceinline__ float wave_max(float v) {
#pragma unroll
    for (int o = 1; o < 64; o <<= 1) v = fmaxf(v, __shfl_xor(v, o));
    return v;
}
__device__ __forceinline__ void p0_row_fp8(const float* src, unsigned char* dst, float* inv_scale, int lane) {
    f32x4 v[4]; float m = 0.f;
#pragma unroll
    for (int j = 0; j < 4; ++j) { v[j] = *(const GAS f32x4*)(src + 16 * lane + 4 * j); m = fmaxf(m, fmaxf(fmaxf(fabsf(v[j].x), fabsf(v[j].y)), fmaxf(fabsf(v[j].z), fabsf(v[j].w)))); }
    m = wave_max(m);
    const float sc = m > 0.f ? 256.0f / m : 1.0f;
    v4u o; unsigned w;
    w = 0u; w = __builtin_amdgcn_cvt_pk_fp8_f32(v[0].x * sc, v[0].y * sc, w, false); w = __builtin_amdgcn_cvt_pk_fp8_f32(v[0].z * sc, v[0].w * sc, w, true); o.x = w;
    w = 0u; w = __builtin_amdgcn_cvt_pk_fp8_f32(v[1].x * sc, v[1].y * sc, w, false); w = __builtin_amdgcn_cvt_pk_fp8_f32(v[1].z * sc, v[1].w * sc, w, true); o.y = w;
    w = 0u; w = __builtin_amdgcn_cvt_pk_fp8_f32(v[2].x * sc, v[2].y * sc, w, false); w = __builtin_amdgcn_cvt_pk_fp8_f32(v[2].z * sc, v[2].w * sc, w, true); o.z = w;
    w = 0u; w = __builtin_amdgcn_cvt_pk_fp8_f32(v[3].x * sc, v[3].y * sc, w, false); w = __builtin_amdgcn_cvt_pk_fp8_f32(v[3].z * sc, v[3].w * sc, w, true); o.w = w;
    *(GAS v4u*)(dst + 16 * lane) = o;
    if (lane == 0) *inv_scale = m > 0.f ? m * (1.0f / 256.0f) : 1.0f;
}
__device__ __forceinline__ void p0_weff_tile(Frame& F, int tile) {
    const int lane = F.lane, r32 = lane & 31, hi = lane >> 5;
    const int it = tile & 31, kt = (tile >> 5) & 3, g = tile >> 7;
    const int h = g >> 1, half = g & 1;
    const float* kp = (half ? F.keys2 : F.keys1) + ((size_t)h * NKEYS + kt * 32 + r32) * 128 + 64 * hi;
    const float* wp = F.w_q + (size_t)(it * 32 + r32) * 2048 + g * 128 + 64 * hi;
    f32x4 a[16], b[16];
#pragma unroll
    for (int j = 0; j < 16; ++j) { a[j] = *(const GAS f32x4*)(kp + 4 * j); b[j] = *(const GAS f32x4*)(wp + 4 * j); }
    f32x16 c = {};
#pragma unroll
    for (int j = 0; j < 16; ++j)
#pragma unroll
        for (int e = 0; e < 4; ++e) c = __builtin_amdgcn_mfma_f32_32x32x2f32(a[j][e], b[j][e], c, 0, 0, 0);
#pragma unroll
    for (int r = 0; r < 16; ++r) { const int row = (r & 3) + 8 * (r >> 2) + 4 * hi;
        F.WeffT[(size_t)(g * 128 + kt * 32 + row) * 1024 + it * 32 + r32] = (bf16)f2bf(c[r]); }
}
__device__ __forceinline__ void p0_prologue(Frame& F) {
    LAS float* scr = (LAS float*)(F.lds + RING_OFF + F.wave * 16384);
    const int gw = F.vcu * NWAVES + F.wave, NGW = F.G * NWAVES;
    constexpr int I_IN = 16 * 128, I_V = 16 * 16, I_P = 8 * 32, I_O = 8 * 32, I_W = 16 * 32;
    constexpr int NITEMS = I_IN + I_V + I_P + I_O + I_W;
    for (int itx = gw; itx < NITEMS; itx += NGW) {
        int r = itx;
        if (r < I_IN) { const int kb = r / 128, nb = r % 128, j0 = nb * 32;
            int oc; if (j0 < 1024) { const int pn = j0 >> 8, w = j0 & 255; oc = (w < 128) ? pn * 128 + w : 512 + pn * 128 + (w - 128); } else if (j0 < 2048) oc = j0; else oc = j0 + 512;
            p0_transpose_item(F.w_in, 4608, oc, kb * 64, F.WinT, 1024, j0, kb * 64, scr, F.lane); continue; } r -= I_IN;
        if (r < I_V) { const int kb = r / 16, nb = r % 16; p0_transpose_item(F.w_in, 4608, 2048 + nb * 32, kb * 64, F.WvT, 1024, nb * 32, kb * 64, scr, F.lane); continue; } r -= I_V;
        if (r < I_P) { const int kb = r / 32, nb = r % 32; p0_transpose_item(F.w_pw2, 1024, nb * 32, kb * 64, F.Wpw2T, 512, nb * 32, kb * 64, scr, F.lane); continue; } r -= I_P;
        if (r < I_O) { const int kb = r / 32, nb = r % 32; p0_transpose_item(F.w_o, 1024, nb * 32, kb * 64, F.WoT, 512, nb * 32, kb * 64, scr, F.lane); continue; } r -= I_O;
        { const int kb = r / 32, nb = r % 32; p0_transpose_item(F.w_out, 1024, nb * 32, kb * 64, F.WoutT, 2048, nb * 32, kb * 64, scr, F.lane);
          p0_transpose_item(F.w_out, 1024, nb * 32, kb * 64, F.WoutT, 2048, nb * 32, 1024 + kb * 64, scr, F.lane); }
    }
    for (int tile = gw; tile < 2048; tile += NGW) p0_weff_tile(F, tile);
    p0_convert(F.x, F.XB, (size_t)T * D / 8, gw, NGW, F.lane);
    for (int r = gw; r < 2 * NEXP; r += NGW) { if (r < NEXP) p0_row_fp8(F.pu + (size_t)r * D, F.UT + (size_t)r * D, F.USC + r, F.lane); else p0_row_fp8(F.pv + (size_t)(r - NEXP) * D, F.VTAB + (size_t)(r - NEXP) * D, F.VSC + (r - NEXP), F.lane); }
}

__device__ __forceinline__ void conv_unit(Frame& F, int ct) {
    const int tid = F.tid, lane = F.lane, w = F.wave;
    const int tb = ct * 64, p0 = tb & (SEQ - 1);
    LAS unsigned char* L = F.lds + RING_OFF;
    for (int c = tid; c < 94 * 64; c += NWAVES * 64) { const int r = c >> 6, ch = c & 63; v4u v = (v4u){0u, 0u, 0u, 0u};
        if (p0 - 30 + r >= 0) v = *(const GAS v4u*)(F.GLU + (size_t)(tb - 30 + r) * CONVD + ch * 8);
        *(LAS v4u*)(L + r * 1024 + ch * 16) = v; }
    __syncthreads();
    float s1[8], s2[8];
#pragma unroll
    for (int i = 0; i < 8; ++i) { s1[i] = 0.f; s2[i] = 0.f; }
#define CONV_BODY() \
        const int p = lane + 64 * q, c0 = 2 * p; \
        const f32x2 bb = *(const GAS f32x2*)(F.cb_dw + c0); \
        float a0[8], a1[8]; \
        _Pragma("unroll") for (int i = 0; i < 8; ++i) { a0[i] = bb.x; a1[i] = bb.y; } \
        float w0[CONVW], w1[CONVW]; \
        _Pragma("unroll") for (int rr = 0; rr < 38; ++rr) { \
            if (rr < CONVW) { const f32x2 ww = *(const GAS f32x2*)(F.cw_dw + rr * CONVD + c0); w0[rr] = ww.x; w1[rr] = ww.y; } \
            const unsigned g2 = *(const LAS unsigned*)(L + (8 * w + rr) * 1024 + p * 4); \
            const float lo = bflo(g2), hi = bfhi(g2); \
            _Pragma("unroll") for (int i = 0; i < 8; ++i) { const int j = rr - i; if (j >= 0 && j < CONVW) { a0[i] += w0[j] * lo; a1[i] += w1[j] * hi; } } \
        }
#pragma unroll 1
    for (int q = 0; q < 4; ++q) {
        CONV_BODY()
#pragma unroll
        for (int i = 0; i < 8; ++i) { s1[i] += a0[i] + a1[i]; s2[i] += a0[i] * a0[i] + a1[i] * a1[i]; }
    }
    float mean[8], rstd[8];
#pragma unroll
    for (int i = 0; i < 8; ++i) { mean[i] = wave_sum(s1[i]) * (1.0f / CONVD); const float var = wave_sum(s2[i]) * (1.0f / CONVD) - mean[i] * mean[i];
        rstd[i] = 1.0f / sqrtf(fmaxf(var, 0.f) + LN_EPS); }
#pragma unroll 1
    for (int q = 0; q < 4; ++q) {
        CONV_BODY()
        const f32x2 gg = *(const GAS f32x2*)(F.cln_g + c0), lb = *(const GAS f32x2*)(F.cln_b + c0);
#pragma unroll
        for (int i = 0; i < 8; ++i) { float v0 = (a0[i] - mean[i]) * rstd[i] * gg.x + lb.x, v1 = (a1[i] - mean[i]) * rstd[i] * gg.y + lb.y;
            v0 = v0 * pg8::sigmoid_f(v0); v1 = v1 * pg8::sigmoid_f(v1);
            *(GAS unsigned*)(F.Cb + (size_t)(tb + 8 * w + i) * CONVD + c0) = pk2(v0, v1); }
    }
#undef CONV_BODY
    __syncthreads();
}

__device__ __forceinline__ unsigned cvtpk_s(float lo, float hi) { typedef float f2 __attribute__((ext_vector_type(2))); typedef __bf16 b2 __attribute__((ext_vector_type(2))); f2 v = {lo, hi}; b2 b = __builtin_convertvector(v, b2); return __builtin_bit_cast(unsigned, b); }
__device__ __forceinline__ void attn_task(Frame& F, int task) {
    const int lane = F.lane, r32 = lane & 31, hi = lane >> 5;
    const int qblk = task & 127, h = (task >> 7) & 7, b = task >> 10;
    const int q0 = qblk * 32; const size_t rowbase = (size_t)b * SEQ;
    bf16x8 qf[4];
#pragma unroll
    for (int d0 = 0; d0 < 4; ++d0) qf[d0] = *(const GAS bf16x8*)(F.Qb + (rowbase + q0 + r32) * SBDIM + h * SBD + d0 * 16 + hi * 8);
    f32x16 o0 = {}, o1 = {};
    float Rc = 1.0f;
    const int kperm = 32 * ((r32 >> 2) & 1) + 4 * (r32 >> 3) + (r32 & 3);
    const int jt0 = q0 >> 6;
    const int qpos = q0 + r32;
    for (int jt = jt0; jt >= 0; --jt) {
        const int t0 = jt * 64;
        bf16x8 kf[2][4];
#pragma unroll
        for (int p = 0; p < 2; ++p)
#pragma unroll
            for (int d0 = 0; d0 < 4; ++d0) kf[p][d0] = *(const GAS bf16x8*)(F.Kb + (rowbase + t0 + kperm + 16 * p) * SBDIM + h * SBD + d0 * 16 + hi * 8);
        bf16x8 vf[2][2][2];
#pragma unroll
        for (int dt = 0; dt < 2; ++dt)
#pragma unroll
            for (int p = 0; p < 2; ++p)
#pragma unroll
                for (int s = 0; s < 2; ++s) vf[dt][p][s] = *(const GAS bf16x8*)(F.VT + (size_t)(h * SBD + dt * 32 + r32) * T + rowbase + t0 + 32 * hi + 16 * p + 8 * s);
        f32x16 sp[2];
#pragma unroll
        for (int p = 0; p < 2; ++p) { sp[p] = (f32x16){};
#pragma unroll
            for (int d0 = 0; d0 < 4; ++d0) sp[p] = __builtin_amdgcn_mfma_f32_32x32x16_bf16(kf[p][d0], qf[d0], sp[p], 0, 0, 0); }
        float rr[32], be[32];
#pragma unroll
        for (int p = 0; p < 2; ++p)
#pragma unroll
            for (int r = 0; r < 16; ++r) { const float e = __builtin_amdgcn_exp2f(sp[p][r]); const float om = __builtin_amdgcn_rcpf(1.0f + e); rr[16 * p + r] = om; be[16 * p + r] = 1.0f - om; }
        if (jt == jt0) {
#pragma unroll
            for (int i = 0; i < 32; ++i) { const bool valid = (t0 + 32 * hi + i) < qpos; rr[i] = valid ? rr[i] : 1.0f; be[i] = valid ? be[i] : 0.0f; }
        }
        float tt[16];
#pragma unroll
        for (int i = 0; i < 16; ++i) tt[i] = rr[2 * i] * rr[2 * i + 1];
#pragma unroll
        for (int i = 0; i < 8; ++i) tt[i] = tt[2 * i] * tt[2 * i + 1];
#pragma unroll
        for (int i = 0; i < 4; ++i) tt[i] = tt[2 * i] * tt[2 * i + 1];
        const float tot = (tt[0] * tt[1]) * (tt[2] * tt[3]);
        const float oth = __shfl_xor(tot, 32);
        float run = hi ? Rc : Rc * oth;
        Rc = Rc * tot * oth;
        float pa[32];
#pragma unroll
        for (int i = 31; i >= 0; --i) { pa[i] = be[i] * run; run *= rr[i]; }
#pragma unroll
        for (int p = 0; p < 2; ++p)
#pragma unroll
            for (int s = 0; s < 2; ++s) { v4u pw; const int bs = 16 * p + 8 * s;
                pw.x = cvtpk_s(pa[bs], pa[bs + 1]); pw.y = cvtpk_s(pa[bs + 2], pa[bs + 3]); pw.z = cvtpk_s(pa[bs + 4], pa[bs + 5]); pw.w = cvtpk_s(pa[bs + 6], pa[bs + 7]);
                const bf16x8 pf = __builtin_bit_cast(bf16x8, pw);
                o0 = __builtin_amdgcn_mfma_f32_32x32x16_bf16(pf, vf[0][p][s], o0, 0, 0, 0);
                o1 = __builtin_amdgcn_mfma_f32_32x32x16_bf16(pf, vf[1][p][s], o1, 0, 0, 0); }
        if (__all(Rc < 1e-12f)) break;
    }
#pragma unroll
    for (int r = 0; r < 16; ++r) { const int q = (r & 3) + 8 * (r >> 2) + 4 * hi; bf16* op = F.AO + (rowbase + q0 + q) * SBDIM + h * SBD + r32;
        op[0] = (bf16)f2bf(o0[r]); op[32] = (bf16)f2bf(o1[r]); }
}

__device__ __forceinline__ void ln1_row(Frame& F, int m) {
    const GAS f32x4* xr = (const GAS f32x4*)(F.R + (size_t)m * D) + F.lane;
    f32x4 v[4]; float s = 0.f;
#pragma unroll
    for (int j = 0; j < 4; ++j) { v[j] = xr[64 * j]; s += (v[j].x + v[j].y) + (v[j].z + v[j].w); }
    const float mean = wave_sum(s) * (1.f / D); float s2 = 0.f;
#pragma unroll
    for (int j = 0; j < 4; ++j) { v[j] = v[j] - mean; s2 += (v[j].x * v[j].x + v[j].y * v[j].y) + (v[j].z * v[j].z + v[j].w * v[j].w); }
    const float rstd = 1.f / sqrtf(wave_sum(s2) * (1.f / D) + LN_EPS);
    GAS v2u* o8 = (GAS v2u*)(F.XB + (size_t)m * D) + F.lane;
#pragma unroll
    for (int j = 0; j < 4; ++j) { const f32x4 gg = *((const GAS f32x4*)F.ln1_g + F.lane + 64 * j), bb = *((const GAS f32x4*)F.ln1_b + F.lane + 64 * j);
        const f32x4 y = v[j] * rstd * gg + bb; v2u o; o.x = pk2(y.x, y.y); o.y = pk2(y.z, y.w); o8[64 * j] = o; }
}

#define CE_DESC(a, b) do { const unsigned _x = (a), _y = (b); (a) = _x > _y ? _x : _y; (b) = _x > _y ? _y : _x; } while (0)
__device__ __forceinline__ unsigned f2key(float f) { const unsigned u = __float_as_uint(f); return (u & 0x80000000u) ? ~u : (u | 0x80000000u); }
__device__ __forceinline__ float key2f(unsigned k) { const unsigned u = (k & 0x80000000u) ? (k & 0x7fffffffu) : ~k; return __uint_as_float(u); }
__device__ __forceinline__ void sort16_desc(unsigned (&a)[16]) {
#pragma unroll
    for (int k = 2; k <= 16; k <<= 1)
#pragma unroll
        for (int j = k >> 1; j > 0; j >>= 1)
#pragma unroll
            for (int i = 0; i < 16; ++i) { const int l = i ^ j; if (l > i) { if ((i & k) == 0) CE_DESC(a[i], a[l]); else CE_DESC(a[l], a[i]); } }
}
__device__ __forceinline__ void merge16_desc(unsigned (&t)[16], const unsigned (&c)[16]) {
#pragma unroll
    for (int i = 0; i < 16; ++i) t[i] = t[i] > c[15 - i] ? t[i] : c[15 - i];
#pragma unroll
    for (int j = 8; j > 0; j >>= 1)
#pragma unroll
        for (int i = 0; i < 16; ++i) { const int l = i ^ j; if (l > i) CE_DESC(t[i], t[l]); }
}
__device__ __forceinline__ void top16_of_128(const float* col, unsigned (&top)[16]) {
#pragma unroll 1
    for (int c = 0; c < 8; ++c) {
        unsigned a[16];
#pragma unroll
        for (int i = 0; i < 16; ++i) { const float v = *(const GAS float*)(col + (size_t)(c * 16 + i) * T); a[i] = (f2key(v) & ~127u) | (unsigned)(127 - (c * 16 + i)); }
        sort16_desc(a);
        if (c == 0) {
#pragma unroll
            for (int i = 0; i < 16; ++i) top[i] = a[i];
        } else merge16_desc(top, a);
    }
}
__device__ __forceinline__ void select_task(Frame& F, int task) {
    const int lane = F.lane, w = F.wave;
    const int h = task & 7, tblk = task >> 3; const int t = tblk * 64 + lane;
    unsigned v1[16], v2[16];
    top16_of_128(F.ST + (size_t)(h * 256) * T + t, v1);
    top16_of_128(F.ST + (size_t)(h * 256 + 128) * T + t, v2);
    LAS unsigned* L = (LAS unsigned*)(F.lds + RING_OFF) + w * 2048;
#pragma unroll
    for (int i = 0; i < 16; ++i) { L[i * 64 + lane] = v1[i]; L[(16 + i) * 64 + lane] = v2[i]; }
    float f1[16], f2[16];
#pragma unroll
    for (int i = 0; i < 16; ++i) { f1[i] = key2f(v1[i] & ~127u); f2[i] = key2f(v2[i] & ~127u); }
    unsigned top[16], cg[16];
#define CAND(i, j) ((f2key(f1[i] + f2[j]) & ~255u) | (unsigned)((i) * 16 + (j)))
#pragma unroll
    for (int j = 0; j < 16; ++j) top[j] = CAND(0, j);
    sort16_desc(top);
#pragma unroll
    for (int j = 0; j < 8; ++j) { cg[j] = CAND(1, j); cg[8 + j] = CAND(8 + j, 0); }
    sort16_desc(cg); merge16_desc(top, cg);
    cg[0] = CAND(2, 0); cg[1] = CAND(2, 1); cg[2] = CAND(2, 2); cg[3] = CAND(2, 3); cg[4] = CAND(2, 4);
    cg[5] = CAND(3, 0); cg[6] = CAND(3, 1); cg[7] = CAND(3, 2); cg[8] = CAND(3, 3);
    cg[9] = CAND(4, 0); cg[10] = CAND(4, 1); cg[11] = CAND(4, 2);
    cg[12] = CAND(5, 0); cg[13] = CAND(5, 1); cg[14] = CAND(6, 0); cg[15] = CAND(6, 1);
    sort16_desc(cg); merge16_desc(top, cg);
    cg[0] = CAND(7, 0); cg[1] = CAND(7, 1);
#pragma unroll
    for (int j = 2; j < 16; ++j) cg[j] = 0u;
    sort16_desc(cg); merge16_desc(top, cg);
#undef CAND
    LDS_WAIT(); asm volatile("" ::: "memory");
    float sv[16]; int ex[16];
#pragma unroll
    for (int j = 0; j < 16; ++j) { const unsigned k = top[j]; const int ci = (k >> 4) & 15, cj = k & 15;
        sv[j] = key2f(k & ~255u);
        const unsigned a = L[ci * 64 + lane], bq = L[(16 + cj) * 64 + lane];
        ex[j] = (127 - (int)(a & 127u)) * NKEYS + (127 - (int)(bq & 127u)); }
    float mx = sv[0], sum = 0.f;
#pragma unroll
    for (int j = 0; j < 16; ++j) { sv[j] = __builtin_amdgcn_exp2f((sv[j] - mx) * 1.4426950408889634f); sum += sv[j]; }
    const float inv = 1.0f / sum;
    GAS v4u* ip = (GAS v4u*)(F.IDX + (size_t)t * 128 + h * 16); GAS f32x4* gp = (GAS f32x4*)(F.GATE + (size_t)t * 128 + h * 16);
#pragma unroll
    for (int j = 0; j < 4; ++j) { ip[j] = (v4u){(unsigned)ex[4 * j], (unsigned)ex[4 * j + 1], (unsigned)ex[4 * j + 2], (unsigned)ex[4 * j + 3]};
        gp[j] = (f32x4){sv[4 * j] * inv, sv[4 * j + 1] * inv, sv[4 * j + 2] * inv, sv[4 * j + 3] * inv}; }
    LDS_WAIT(); asm volatile("" ::: "memory");
}

__device__ __forceinline__ float dot2bf(unsigned a, unsigned b, float acc) {
    typedef __bf16 b2 __attribute__((ext_vector_type(2)));
    return __builtin_amdgcn_fdot2_f32_bf16(__builtin_bit_cast(b2, a), __builtin_bit_cast(b2, b), acc, false);
}
__device__ __forceinline__ float gelu_erf(float v) {
    const float av = fabsf(v), t = __builtin_amdgcn_rcpf(av * 0.2316418882f + 1.0f);
    float q = t * 0.5307027145f + (-0.7265760135f); q = q * t + 0.7107068705f; q = q * t + (-0.142248368f); q = q * t + 0.127414796f; q = q * t;
    const float e = __builtin_amdgcn_exp2f((v * v) * (-0.72134752044f));
    const float m = v * (q * e);
    return v < 0.f ? m : v - m;
}
#define DPPF(v, ctrl) __builtin_bit_cast(float, __builtin_amdgcn_update_dpp(0, __builtin_bit_cast(int, (v)), (ctrl), 0xF, 0xF, true))
__device__ __forceinline__ float row16_sum(float v) {
    v += DPPF(v, 0xB1); v += DPPF(v, 0x4E); v += DPPF(v, 0x141); v += DPPF(v, 0x140); return v;
}
__device__ __forceinline__ float xgroup_sum(float v) {
    { auto r = __builtin_amdgcn_permlane16_swap(__float_as_uint(v), __float_as_uint(v), false, false); v = __uint_as_float(r[0]) + __uint_as_float(r[1]); }
    { auto r = __builtin_amdgcn_permlane32_swap(__float_as_uint(v), __float_as_uint(v), false, false); v = __uint_as_float(r[0]) + __uint_as_float(r[1]); }
    return v;
}
__device__ __forceinline__ void peer_token(Frame& F, int t) {
    const int lane = F.lane, grp = lane >> 4, i16 = lane & 15;
    LAS int* Lidx = (LAS int*)(F.lds + RING_OFF + F.wave * 2048);
    LAS float* Lco = (LAS float*)(Lidx + 128);
    LAS float* Lgate = (LAS float*)(Lidx + 256);
    Lidx[lane] = F.IDX[(size_t)t * 128 + lane]; Lidx[lane + 64] = F.IDX[(size_t)t * 128 + 64 + lane];
    Lgate[lane] = F.GATE[(size_t)t * 128 + lane]; Lgate[lane + 64] = F.GATE[(size_t)t * 128 + 64 + lane];
#define X_LOAD(dst) do { const GAS v4u* xrow = (const GAS v4u*)(F.XB + (size_t)t * D); \
        _Pragma("unroll") for (int j = 0; j < 4; ++j) { const v4u a = xrow[(j * 16 + i16) * 2], b = xrow[(j * 16 + i16) * 2 + 1]; \
            dst[16 * j + 0] = bflo(a.x); dst[16 * j + 1] = bfhi(a.x); dst[16 * j + 2] = bflo(a.y); dst[16 * j + 3] = bfhi(a.y); dst[16 * j + 4] = bflo(a.z); dst[16 * j + 5] = bfhi(a.z); dst[16 * j + 6] = bflo(a.w); dst[16 * j + 7] = bfhi(a.w); \
            dst[16 * j + 8] = bflo(b.x); dst[16 * j + 9] = bfhi(b.x); dst[16 * j + 10] = bflo(b.y); dst[16 * j + 11] = bfhi(b.y); dst[16 * j + 12] = bflo(b.z); dst[16 * j + 13] = bfhi(b.z); dst[16 * j + 14] = bflo(b.w); dst[16 * j + 15] = bfhi(b.w); } } while (0)
    float xf[64];
    X_LOAD(xf);
    LDS_WAIT(); asm volatile("" ::: "memory");
    v4u b0[4], b1[4], b2[4], b3[4];
#define T_LOAD(buf, TAB, itn) do { const int e_ = Lidx[(itn) * 4 + grp]; const GAS v4u* p_ = (const GAS v4u*)((TAB) + (size_t)e_ * D) + i16; \
        _Pragma("unroll") for (int j = 0; j < 4; ++j) buf[j] = p_[j * 16]; } while (0)
#define U_DOT(buf, itn) do { float d_ = 0.f; \
        _Pragma("unroll") for (int j = 0; j < 4; ++j) { \
            const f32x2 p0_ = __builtin_amdgcn_cvt_pk_f32_fp8(buf[j].x, false), p1_ = __builtin_amdgcn_cvt_pk_f32_fp8(buf[j].x, true), p2_ = __builtin_amdgcn_cvt_pk_f32_fp8(buf[j].y, false), p3_ = __builtin_amdgcn_cvt_pk_f32_fp8(buf[j].y, true); \
            const f32x2 p4_ = __builtin_amdgcn_cvt_pk_f32_fp8(buf[j].z, false), p5_ = __builtin_amdgcn_cvt_pk_f32_fp8(buf[j].z, true), p6_ = __builtin_amdgcn_cvt_pk_f32_fp8(buf[j].w, false), p7_ = __builtin_amdgcn_cvt_pk_f32_fp8(buf[j].w, true); \
            d_ += p0_.x * xf[16 * j + 0]; d_ += p0_.y * xf[16 * j + 1]; d_ += p1_.x * xf[16 * j + 2]; d_ += p1_.y * xf[16 * j + 3]; \
            d_ += p2_.x * xf[16 * j + 4]; d_ += p2_.y * xf[16 * j + 5]; d_ += p3_.x * xf[16 * j + 6]; d_ += p3_.y * xf[16 * j + 7]; \
            d_ += p4_.x * xf[16 * j + 8]; d_ += p4_.y * xf[16 * j + 9]; d_ += p5_.x * xf[16 * j + 10]; d_ += p5_.y * xf[16 * j + 11]; \
            d_ += p6_.x * xf[16 * j + 12]; d_ += p6_.y * xf[16 * j + 13]; d_ += p7_.x * xf[16 * j + 14]; d_ += p7_.y * xf[16 * j + 15]; } \
        d_ = row16_sum(d_); if (i16 == 0) Lco[(itn) * 4 + grp] = d_; } while (0)
    T_LOAD(b0, F.UT, 0); T_LOAD(b1, F.UT, 1); T_LOAD(b2, F.UT, 2);
#pragma unroll 1
    for (int it = 0; it < 32; it += 4) {
        T_LOAD(b3, F.UT, it + 3); U_DOT(b0, it);
        if (it + 4 < 32) T_LOAD(b0, F.UT, it + 4); U_DOT(b1, it + 1);
        if (it + 5 < 32) T_LOAD(b1, F.UT, it + 5); U_DOT(b2, it + 2);
        if (it + 6 < 32) T_LOAD(b2, F.UT, it + 6); U_DOT(b3, it + 3);
    }
#undef U_DOT
    LDS_WAIT(); asm volatile("" ::: "memory");
    { const int e0 = Lidx[lane], e1 = Lidx[lane + 64];
      const float c0 = Lgate[lane] * gelu_erf(Lco[lane] * F.USC[e0]) * F.VSC[e0], c1 = Lgate[lane + 64] * gelu_erf(Lco[lane + 64] * F.USC[e1]) * F.VSC[e1];
      Lco[lane] = c0; Lco[lane + 64] = c1; }
    LDS_WAIT(); asm volatile("" ::: "memory");
    float acc[64];
#pragma unroll
    for (int k = 0; k < 64; ++k) acc[k] = 0.f;
#define V_ACC(buf, itn) do { const float cf_ = Lco[(itn) * 4 + grp]; \
        _Pragma("unroll") for (int j = 0; j < 4; ++j) { \
            const f32x2 p0_ = __builtin_amdgcn_cvt_pk_f32_fp8(buf[j].x, false), p1_ = __builtin_amdgcn_cvt_pk_f32_fp8(buf[j].x, true), p2_ = __builtin_amdgcn_cvt_pk_f32_fp8(buf[j].y, false), p3_ = __builtin_amdgcn_cvt_pk_f32_fp8(buf[j].y, true); \
            const f32x2 p4_ = __builtin_amdgcn_cvt_pk_f32_fp8(buf[j].z, false), p5_ = __builtin_amdgcn_cvt_pk_f32_fp8(buf[j].z, true), p6_ = __builtin_amdgcn_cvt_pk_f32_fp8(buf[j].w, false), p7_ = __builtin_amdgcn_cvt_pk_f32_fp8(buf[j].w, true); \
            acc[16 * j + 0] += cf_ * p0_.x; acc[16 * j + 1] += cf_ * p0_.y; acc[16 * j + 2] += cf_ * p1_.x; acc[16 * j + 3] += cf_ * p1_.y; \
            acc[16 * j + 4] += cf_ * p2_.x; acc[16 * j + 5] += cf_ * p2_.y; acc[16 * j + 6] += cf_ * p3_.x; acc[16 * j + 7] += cf_ * p3_.y; \
            acc[16 * j + 8] += cf_ * p4_.x; acc[16 * j + 9] += cf_ * p4_.y; acc[16 * j + 10] += cf_ * p5_.x; acc[16 * j + 11] += cf_ * p5_.y; \
            acc[16 * j + 12] += cf_ * p6_.x; acc[16 * j + 13] += cf_ * p6_.y; acc[16 * j + 14] += cf_ * p7_.x; acc[16 * j + 15] += cf_ * p7_.y; } } while (0)
    T_LOAD(b0, F.VTAB, 0); T_LOAD(b1, F.VTAB, 1); T_LOAD(b2, F.VTAB, 2);
#pragma unroll 1
    for (int it = 0; it < 32; it += 4) {
        T_LOAD(b3, F.VTAB, it + 3); V_ACC(b0, it);
        if (it + 4 < 32) T_LOAD(b0, F.VTAB, it + 4); V_ACC(b1, it + 1);
        if (it + 5 < 32) T_LOAD(b1, F.VTAB, it + 5); V_ACC(b2, it + 2);
        if (it + 6 < 32) T_LOAD(b2, F.VTAB, it + 6); V_ACC(b3, it + 3);
    }
#undef V_ACC
#undef T_LOAD
#pragma unroll
    for (int k = 0; k < 64; ++k) acc[k] = xgroup_sum(acc[k]);
    asm volatile("" ::: "memory");
    { float xr[64]; X_LOAD(xr);
#pragma unroll
      for (int k = 0; k < 64; ++k) acc[k] += ALPHA * xr[k]; }
#undef X_LOAD
    float s = 0.f;
#pragma unroll
    for (int k = 0; k < 64; ++k) s += acc[k];
    const float mean = row16_sum(s) * (1.0f / D); float s2 = 0.f;
#pragma unroll
    for (int k = 0; k < 64; ++k) { acc[k] -= mean; s2 += acc[k] * acc[k]; }
    const float rstd = 1.0f / sqrtf(row16_sum(s2) * (1.0f / D) + LN_EPS);
#pragma unroll
    for (int j = 0; j < 4; ++j) if (j == grp) {
        const int col = (j * 16 + i16) * 16;
#pragma unroll
        for (int q = 0; q < 4; ++q) { const f32x4 g = *(const GAS f32x4*)(F.ln2_g + col + 4 * q), b = *(const GAS f32x4*)(F.ln2_b + col + 4 * q);
            f32x4 y; y.x = acc[16 * j + 4 * q + 0] * rstd * g.x + b.x; y.y = acc[16 * j + 4 * q + 1] * rstd * g.y + b.y; y.z = acc[16 * j + 4 * q + 2] * rstd * g.z + b.z; y.w = acc[16 * j + 4 * q + 3] * rstd * g.w + b.w;
            *(GAS f32x4*)(F.out + (size_t)t * D + col + 4 * q) = y; } }
    LDS_WAIT(); asm volatile("" ::: "memory");
}

struct Args { const float* in[21]; float* out; unsigned char* ws; int ph_lo, ph_hi, li, pad; };
__global__ void __launch_bounds__(NWAVES * 64, 2) fwd_kernel(Args args) {
    extern __shared__ __attribute__((aligned(16))) unsigned char lds[];
    Frame F;
    F.lds = (LAS unsigned char*)lds;
    F.MISC = (volatile LAS unsigned*)(F.lds + MISC_OFF);
    F.tid = threadIdx.x; F.lane = F.tid & 63; F.wave = __builtin_amdgcn_readfirstlane(F.tid >> 6);
    F.G = gridDim.x; { const int bx = blockIdx.x; F.vcu = (F.G % 8 == 0) ? (bx % 8) * (F.G / 8) + bx / 8 : bx; }
    unsigned char* ws = args.ws;
    F.ctl = (gu32*)(ws + WS_CTL);
    F.x = args.in[0]; F.w_in = args.in[1]; F.b_in = args.in[2]; F.cw_dw = args.in[3]; F.cb_dw = args.in[4]; F.cln_g = args.in[5]; F.cln_b = args.in[6];
    F.w_pw2 = args.in[7]; F.b_pw2 = args.in[8]; F.w_o = args.in[9]; F.w_out = args.in[10]; F.b_out = args.in[11]; F.ln1_g = args.in[12]; F.ln1_b = args.in[13];
    F.w_q = args.in[14]; F.keys1 = args.in[15]; F.keys2 = args.in[16]; F.pu = args.in[17]; F.pv = args.in[18]; F.ln2_g = args.in[19]; F.ln2_b = args.in[20];
    F.out = args.out;
    F.WinT = (bf16*)(ws + WS_WIN); F.WvT = (bf16*)(ws + WS_WV); F.Wpw2T = (bf16*)(ws + WS_WPW2); F.WoT = (bf16*)(ws + WS_WO); F.WoutT = (bf16*)(ws + WS_WOUT); F.WeffT = (bf16*)(ws + WS_WEFF);
    F.UT = ws + WS_UT; F.VTAB = ws + WS_VTAB; F.USC = (float*)(ws + WS_USC); F.VSC = (float*)(ws + WS_VSC); F.XB = (bf16*)(ws + WS_XB); F.Cb = (bf16*)(ws + WS_C); F.AO = (bf16*)(ws + WS_AO);
    F.GLU = (bf16*)(ws + WS_GLU); F.Qb = (bf16*)(ws + WS_Q); F.Kb = (bf16*)(ws + WS_K); F.VT = (bf16*)(ws + WS_VT); F.M2 = (bf16*)(ws + WS_M2); F.Gt = (bf16*)(ws + WS_G);
    F.R = (float*)(ws + WS_R); F.ST = (float*)(ws + WS_ST); F.GATE = (float*)(ws + WS_GATE); F.IDX = (int*)(ws + WS_IDX);
    for (int u = F.tid; u < (LDS_BYTES - LDSCTL_OFF) / 4; u += NWAVES * 64) ((LAS unsigned*)(F.lds + LDSCTL_OFF))[u] = 0u;
    __syncthreads();
    XcdBarrier bar; bar.bar = (unsigned*)(F.ctl + CW_BAR); bar.x = 0; bar.st = nullptr;
    if (MK_N_LAUNCHES == 1) bar = xcd_barrier_post((unsigned*)(F.ctl + CW_BAR), F.MISC + 8);
#define GRID_BAR() do { if (MK_N_LAUNCHES == 1) xcd_barrier(bar); } while (0)
    const int lo = args.ph_lo, hi = args.ph_hi;
#ifdef ONLY_PHASE
#define IN(k) ((k) == ONLY_PHASE && lo <= (k) && (k) < hi)
#elif defined(DBG_STOP)
#define IN(k) ((k) <= DBG_STOP && lo <= (k) && (k) < hi)
#else
#define IN(k) (lo <= (k) && (k) < hi)
#endif
#define BOTH(k) (IN(k) && IN((k) + 1))
    const int gw = F.vcu * NWAVES + F.wave, NGW = F.G * NWAVES;

    if (IN(0)) { p0_prologue(F); if (BOTH(0)) GRID_BAR(); }

    if (IN(1)) {
        { pg8::Gemm g{F.XB, F.WinT, T, NIN, D, D, D}; pg8::StaticOrder S; S.init(T, NIN, F.G, (int)blockIdx.x);
          pg8::EpiIn E{F.b_in, F.GLU, F.Qb, F.Kb, F.Gt, QSCALE};
          pg8::gemm_phase<pg8::EpiIn, pg8::StaticOrder, true, true>(F.lds + RING_OFF, g, S, E); }
        { pg8::Gemm g{F.WvT, F.XB, SBDIM, T, D, D, D}; pg8::StaticOrder S; S.init(SBDIM, T, F.G, (int)blockIdx.x);
          pg8::EpiVT E{F.b_in + 2048, F.VT, T};
          __syncthreads();
          pg8::gemm_phase<pg8::EpiVT, pg8::StaticOrder, false, true>(F.lds + RING_OFF, g, S, E); }
        if (BOTH(1)) GRID_BAR();
    }

    if (IN(2)) {
        for (int ct = F.vcu; ct < T / 64; ct += F.G) conv_unit(F, ct);
        for (int task = gw; task < BATCH * SBH * (SEQ / 32); task += NGW) attn_task(F, task);
        if (BOTH(2)) GRID_BAR();
    }

    if (IN(3)) {
        { pg8::Gemm g{F.Cb, F.Wpw2T, T, D, CONVD, CONVD, CONVD}; pg8::StaticOrder S; S.init(T, D, F.G, (int)blockIdx.x);
          pg8::EpiGate E{F.b_pw2, F.Gt, F.M2, 0, 0};
          pg8::gemm_phase<pg8::EpiGate, pg8::StaticOrder, true, true>(F.lds + RING_OFF, g, S, E); }
        { pg8::Gemm g{F.AO, F.WoT, T, D, SBDIM, SBDIM, SBDIM}; pg8::StaticOrder S; S.init(T, D, F.G, (int)blockIdx.x);
          pg8::EpiGate E{nullptr, F.Gt, F.M2, 1024, 1024};
          pg8::gemm_phase<pg8::EpiGate, pg8::StaticOrder, true, true>(F.lds + RING_OFF, g, S, E); }
        if (BOTH(3)) GRID_BAR();
    }

    if (IN(4)) {
        pg8::Gemm g{F.M2, F.WoutT, T, D, 2048, 2048, 2048}; pg8::StaticOrder S; S.init(T, D, F.G, (int)blockIdx.x);
        pg8::EpiRes E{F.R, F.x, F.b_out, ALPHA, D};
        pg8::gemm_phase<pg8::EpiRes, pg8::StaticOrder, true, true>(F.lds + RING_OFF, g, S, E);
        if (BOTH(4)) GRID_BAR();
    }

    if (IN(5)) {
        for (int m = gw; m < T; m += NGW) ln1_row(F, m);
        if (BOTH(5)) GRID_BAR();
    }

    if (IN(6)) {
        pg8::Gemm g{F.WeffT, F.XB, 2048, T, D, D, D}; pg8::StaticOrder S; S.init(2048, T, F.G, (int)blockIdx.x);
        pg8::EpiF32 E{F.ST, T};
        pg8::gemm_phase<pg8::EpiF32, pg8::StaticOrder, true, true>(F.lds + RING_OFF, g, S, E);
        if (BOTH(6)) GRID_BAR();
    }

    if (IN(7)) {
        for (int task = gw; task < (T / 64) * PH; task += NGW) select_task(F, task);
        if (BOTH(7)) GRID_BAR();
    }

    if (IN(8)) {
        for (int t = gw; t < T; t += NGW) peer_token(F, t);
    }
#ifdef DBG_STOP
    if (lo <= 8 && 8 < hi) {
        GRID_BAR();
        { const unsigned long long t0 = __builtin_amdgcn_s_memrealtime(); while (__builtin_amdgcn_s_memrealtime() - t0 < 30000ull) __builtin_amdgcn_s_sleep(32); }
        GRID_BAR();
        const size_t n4 = (size_t)T * D / 4;
        for (size_t i = (size_t)gw * 64 + F.lane; i < n4; i += (size_t)NGW * 64) {
            f32x4 v = (f32x4){0.f, 0.f, 0.f, 0.f};
            if (DBG_STOP == 4) { v = ((const GAS f32x4*)F.R)[i]; v = (f32x4){bflo(f2bf(v.x)), bflo(f2bf(v.y)), bflo(f2bf(v.z)), bflo(f2bf(v.w))}; }
            else if (DBG_STOP == 3) { const v2u w = ((const GAS v2u*)F.M2)[i]; const v2u w2 = ((const GAS v2u*)F.M2)[i + n4]; v = (f32x4){bflo(w.x) + bflo(w2.x), bfhi(w.x) + bfhi(w2.x), bflo(w.y) + bflo(w2.y), bfhi(w.y) + bfhi(w2.y)}; }
            else if (DBG_STOP == 2) { const size_t r = i / 256, c4 = i % 256; const bf16* src = (c4 < 128) ? F.Cb + r * 512 + c4 * 4 : F.AO + r * 512 + (c4 - 128) * 4; const v2u w = *(const GAS v2u*)src; v = (f32x4){bflo(w.x), bfhi(w.x), bflo(w.y), bfhi(w.y)}; }
            else if (DBG_STOP == 1) { const v2u w = ((const GAS v2u*)F.Gt)[i]; v = (f32x4){bflo(w.x), bfhi(w.x), bflo(w.y), bfhi(w.y)}; }
            else if (DBG_STOP == 5) { const v2u w = ((const GAS v2u*)F.XB)[i]; v = (f32x4){bflo(w.x), bfhi(w.x), bflo(w.y), bfhi(w.y)}; }
            else if (DBG_STOP == 6) v = ((const GAS f32x4*)F.ST)[i] + ((const GAS f32x4*)F.ST)[i + n4];
            else if (DBG_STOP == 7) { if (i < (size_t)T * 32) { const v4u w = ((const GAS v4u*)F.IDX)[i]; v = (f32x4){(float)w.x, (float)w.y, (float)w.z, (float)w.w}; } else if (i < (size_t)T * 64) v = ((const GAS f32x4*)F.GATE)[i - (size_t)T * 32]; }
            ((GAS f32x4*)F.out)[i] = v; }
    }
#endif
#undef IN
#undef BOTH
}

extern "C" void kernel_launch(void* const* d_in, const int* in_sizes, int n_in, void* d_out, int out_size, void* d_ws, size_t ws_size, hipStream_t stream) {
    static int grid = 0;
    if (grid == 0) {
        if (n_in != 21 || in_sizes[0] != T * D || out_size != T * D || ws_size < WS_END) { fprintf(stderr, "kernel_launch: unexpected shapes (n_in %d, in0 %d, out %d, ws %zu); nothing launched\n", n_in, n_in > 0 ? in_sizes[0] : -1, out_size, ws_size); grid = -1; return; }
        int dev = 0, cus = 0, per_cu = 0;
        if (hipGetDevice(&dev) != hipSuccess || hipDeviceGetAttribute(&cus, hipDeviceAttributeMultiprocessorCount, dev) != hipSuccess) { grid = -1; return; }
        if (hipFuncSetAttribute((const void*)fwd_kernel, hipFuncAttributeMaxDynamicSharedMemorySize, LDS_BYTES) != hipSuccess) { fprintf(stderr, "kernel_launch: hipFuncSetAttribute failed\n"); grid = -1; return; }
        if (hipOccupancyMaxActiveBlocksPerMultiprocessor(&per_cu, (const void*)fwd_kernel, NWAVES * 64, LDS_BYTES) != hipSuccess || per_cu < 1)
            fprintf(stderr, "kernel_launch: note: occupancy query reports %d workgroups per CU\n", per_cu);
        (void)hipGetLastError();
        grid = cus;
    }
    if (grid < 0) return;
    if (hipMemsetAsync((char*)d_ws + WS_CTL, 0, CTL_ZERO_BYTES, stream) != hipSuccess) return;
    Args a{};
    for (int i = 0; i < 21; ++i) a.in[i] = (const float*)d_in[i];
    a.out = (float*)d_out; a.ws = (unsigned char*)d_ws;
    for (int li = 0; li < MK_N_LAUNCHES; ++li) {
        a.ph_lo = (MK_N_LAUNCHES == 1) ? 0 : li; a.ph_hi = (MK_N_LAUNCHES == 1) ? N_PHASES : li + 1; a.li = li;
        hipLaunchKernelGGL(fwd_kernel, dim3(grid), dim3(NWAVES * 64), LDS_BYTES, stream, a);
    }
}
```

```cpp
#include <hip/hip_runtime.h>
#include <hip/hip_bf16.h>
#include <cstdio>
#include <cstdint>
#include <cmath>

#ifndef REPEAT_MASK
#define REPEAT_MASK 0
#endif
#define REP(k) ((REPEAT_MASK >> (k)) & 1)
#ifndef MK_N_LAUNCHES
#define MK_N_LAUNCHES 1
#endif

namespace pg8 {
#define PG8_LAS __attribute__((address_space(3)))
typedef unsigned short bf16_t;
typedef short bf16x8 __attribute__((ext_vector_type(8)));
typedef float f32x4 __attribute__((ext_vector_type(4)));
typedef unsigned u32x4 __attribute__((ext_vector_type(4)));
constexpr int BM = 256, BK = 64, HALF = 128, HTB = HALF * BK * 2, STAGE_BYTES = 8 * HTB, NXCD = 8, WGM = 8;

__host__ __device__ __forceinline__ int lds_byte(int r, int c) { const int st = (r >> 4) * 2 + (c >> 5), rr = r & 15, cc = c & 31, ob = rr * 64 + cc * 2; return st * 1024 + (ob ^ (((ob >> 9) & 1) << 5)); }
__host__ __device__ __forceinline__ void stage_rc(int b, int& R, int& C) { const int st = b / 1024, sb = b % 1024, swz = sb ^ (((sb >> 9) & 1) << 5); R = (st >> 1) * 16 + swz / 64; C = (st & 1) * 32 + (swz % 64) / 2; }
__host__ __device__ __forceinline__ int perm32(int rho) { const int n = rho >> 4, i = rho & 15; return 8 * (i >> 2) + 4 * n + (i & 3); }

struct Unit { int pm, pn; };
struct Gemm { const bf16_t* A; const bf16_t* Bt; int M, N, K, lda, ldb; };

struct StaticOrder {
    int nM, nN, nwg, G, c;
    __host__ __device__ void init(int M, int N, int G_, int c_) { nM = M / BM; nN = N / BM; nwg = nM * nN; G = G_; c = c_; }
    __host__ __device__ bool next(int i, Unit& u) const {
        const long L = (long)i * G + c; if (L >= nwg) return false;
        int wgid = (int)L; { const int q = nwg / NXCD, r = nwg % NXCD, xcd = wgid % NXCD, off = wgid / NXCD; wgid = (xcd < r ? xcd * (q + 1) : r * (q + 1) + (xcd - r) * q) + off; }
        const int nig = WGM * nN, gid = wgid / nig, fm = gid * WGM, gsz = (nM - fm) < WGM ? (nM - fm) : WGM;
        u.pm = fm + ((wgid % nig) % gsz); u.pn = (wgid % nig) / gsz; return true;
    }
    __device__ __forceinline__ void a_ready(const Unit&) const {}
    __device__ __forceinline__ void done(const Unit&) const {}
};

__device__ __forceinline__ unsigned cvt_pk_bf16(float lo, float hi) { typedef float f2_t __attribute__((ext_vector_type(2))); typedef __bf16 b2_t __attribute__((ext_vector_type(2))); f2_t v = {lo, hi}; b2_t b = __builtin_convertvector(v, b2_t); return __builtin_bit_cast(unsigned, b); }
__device__ __forceinline__ float sigmoid_f(float x) { return __builtin_amdgcn_rcpf(1.0f + __builtin_amdgcn_exp2f(-1.4426950408889634f * x)); }

struct EpiF32 {
    static constexpr bool PERM = false, AFTER_DRAIN = false;
    float* C; int ldc;
    __device__ __forceinline__ void operator()(const f32x4 (&acc)[2][2][4][2], const Unit& u, int wr, int wc, int fr, int fq) const {
        const int row0 = u.pm * BM + wr * 64 + fr, col0 = u.pn * BM + wc * 32 + 4 * fq;
#pragma unroll
        for (int ai = 0; ai < 2; ++ai)
#pragma unroll
            for (int m = 0; m < 4; ++m) { float* rowp = C + (size_t)(row0 + ai * HALF + m * 16) * ldc + col0;
#pragma unroll
                for (int bj = 0; bj < 2; ++bj)
#pragma unroll
                    for (int n = 0; n < 2; ++n) *(f32x4*)(rowp + bj * HALF + n * 16) = acc[ai][bj][m][n]; }
    }
};
struct EpiRes {
    static constexpr bool PERM = false, AFTER_DRAIN = false;
    float* C; const float* X; const float* bias; float alpha; int ldc;
    __device__ __forceinline__ void operator()(const f32x4 (&acc)[2][2][4][2], const Unit& u, int wr, int wc, int fr, int fq) const {
        const int row0 = u.pm * BM + wr * 64 + fr, col0 = u.pn * BM + wc * 32 + 4 * fq;
        f32x4 bv[2][2];
#pragma unroll
        for (int bj = 0; bj < 2; ++bj)
#pragma unroll
            for (int n = 0; n < 2; ++n) bv[bj][n] = *(const f32x4*)(bias + col0 + bj * HALF + n * 16);
#pragma unroll
        for (int ai = 0; ai < 2; ++ai)
#pragma unroll
            for (int m = 0; m < 4; ++m) { const size_t off = (size_t)(row0 + ai * HALF + m * 16) * ldc + col0;
#pragma unroll
                for (int bj = 0; bj < 2; ++bj)
#pragma unroll
                    for (int n = 0; n < 2; ++n) { const f32x4 xv = *(const f32x4*)(X + off + bj * HALF + n * 16);
                        *(f32x4*)(C + off + bj * HALF + n * 16) = acc[ai][bj][m][n] + bv[bj][n] + xv * alpha; } }
    }
};
struct EpiIn {
    static constexpr bool PERM = true, AFTER_DRAIN = false;
    const float* b_in; bf16_t* GLU; bf16_t* Q; bf16_t* Kb; bf16_t* G; float qscale;
    __device__ __forceinline__ void operator()(const f32x4 (&acc)[2][2][4][2], const Unit& u, int wr, int wc, int fr, int fq) const {
        const int row0 = u.pm * BM + wr * 64 + fr; const int cw = wc * 32 + 8 * fq;
        if (u.pn < 4) {
            const int oc = u.pn * 128 + cw;
            const f32x4 ba0 = *(const f32x4*)(b_in + oc), ba1 = *(const f32x4*)(b_in + oc + 4), bg0 = *(const f32x4*)(b_in + 512 + oc), bg1 = *(const f32x4*)(b_in + 512 + oc + 4);
#pragma unroll
            for (int ai = 0; ai < 2; ++ai)
#pragma unroll
                for (int m = 0; m < 4; ++m) { const size_t row = (size_t)(row0 + ai * HALF + m * 16);
                    const f32x4 a0 = acc[ai][0][m][0] + ba0, a1 = acc[ai][0][m][1] + ba1, g0 = acc[ai][1][m][0] + bg0, g1 = acc[ai][1][m][1] + bg1;
                    u32x4 w;
                    w.x = cvt_pk_bf16(a0[0] * sigmoid_f(g0[0]), a0[1] * sigmoid_f(g0[1])); w.y = cvt_pk_bf16(a0[2] * sigmoid_f(g0[2]), a0[3] * sigmoid_f(g0[3]));
                    w.z = cvt_pk_bf16(a1[0] * sigmoid_f(g1[0]), a1[1] * sigmoid_f(g1[1])); w.w = cvt_pk_bf16(a1[2] * sigmoid_f(g1[2]), a1[3] * sigmoid_f(g1[3]));
                    *(u32x4*)(GLU + row * 512 + oc) = w; }
        } else if (u.pn < 8) {
            const int which = (u.pn - 4) >> 1; bf16_t* base = which ? Kb : Q; const float sc = which ? 1.0f : qscale;
#pragma unroll
            for (int bj = 0; bj < 2; ++bj) { const int cwithin = ((u.pn - 4) & 1) * 256 + bj * HALF + cw; const int ocol = 1024 + which * 512 + cwithin;
                const f32x4 b0 = *(const f32x4*)(b_in + ocol), b1 = *(const f32x4*)(b_in + ocol + 4);
#pragma unroll
                for (int ai = 0; ai < 2; ++ai)
#pragma unroll
                    for (int m = 0; m < 4; ++m) { const size_t row = (size_t)(row0 + ai * HALF + m * 16);
                        const f32x4 v0 = (acc[ai][bj][m][0] + b0) * sc, v1 = (acc[ai][bj][m][1] + b1) * sc;
                        u32x4 w; w.x = cvt_pk_bf16(v0[0], v0[1]); w.y = cvt_pk_bf16(v0[2], v0[3]); w.z = cvt_pk_bf16(v1[0], v1[1]); w.w = cvt_pk_bf16(v1[2], v1[3]);
                        *(u32x4*)(base + row * 512 + cwithin) = w; } }
        } else {
#pragma unroll
            for (int bj = 0; bj < 2; ++bj) { const int gcol = (u.pn - 8) * 256 + bj * HALF + cw; const int ocol = 2560 + gcol;
                const f32x4 b0 = *(const f32x4*)(b_in + ocol), b1 = *(const f32x4*)(b_in + ocol + 4);
#pragma unroll
                for (int ai = 0; ai < 2; ++ai)
#pragma unroll
                    for (int m = 0; m < 4; ++m) { const size_t row = (size_t)(row0 + ai * HALF + m * 16);
                        const f32x4 v0 = acc[ai][bj][m][0] + b0, v1 = acc[ai][bj][m][1] + b1;
#ifdef DBG_NOSIG
                        u32x4 w; w.x = cvt_pk_bf16(v0[0], v0[1]); w.y = cvt_pk_bf16(v0[2], v0[3]); w.z = cvt_pk_bf16(v1[0], v1[1]); w.w = cvt_pk_bf16(v1[2], v1[3]);
#else
                        u32x4 w; w.x = cvt_pk_bf16(sigmoid_f(v0[0]), sigmoid_f(v0[1])); w.y = cvt_pk_bf16(sigmoid_f(v0[2]), sigmoid_f(v0[3]));
                        w.z = cvt_pk_bf16(sigmoid_f(v1[0]), sigmoid_f(v1[1])); w.w = cvt_pk_bf16(sigmoid_f(v1[2]), sigmoid_f(v1[3]));
#endif
                        *(u32x4*)(G + row * 2048 + gcol) = w; } }
        }
    }
};
struct EpiVT {
    static constexpr bool PERM = true, AFTER_DRAIN = false;
    const float* rbias; bf16_t* O; int ldc;
    __device__ __forceinline__ void operator()(const f32x4 (&acc)[2][2][4][2], const Unit& u, int wr, int wc, int fr, int fq) const {
        const int row0 = u.pm * BM + wr * 64 + fr; const int col0 = u.pn * BM + wc * 32 + 8 * fq;
#pragma unroll
        for (int ai = 0; ai < 2; ++ai)
#pragma unroll
            for (int m = 0; m < 4; ++m) { const int row = row0 + ai * HALF + m * 16; const float rb = rbias[row];
#pragma unroll
                for (int bj = 0; bj < 2; ++bj) { const f32x4 v0 = acc[ai][bj][m][0] + rb, v1 = acc[ai][bj][m][1] + rb;
                    u32x4 w; w.x = cvt_pk_bf16(v0[0], v0[1]); w.y = cvt_pk_bf16(v0[2], v0[3]); w.z = cvt_pk_bf16(v1[0], v1[1]); w.w = cvt_pk_bf16(v1[2], v1[3]);
                    *(u32x4*)(O + (size_t)row * ldc + col0 + bj * HALF) = w; } }
    }
};
struct EpiGate {
    static constexpr bool PERM = true, AFTER_DRAIN = false;
    const float* bias; const bf16_t* Gt; bf16_t* O; int gcol0, ocol0;
    __device__ __forceinline__ void operator()(const f32x4 (&acc)[2][2][4][2], const Unit& u, int wr, int wc, int fr, int fq) const {
        const int row0 = u.pm * BM + wr * 64 + fr; const int col0 = u.pn * BM + wc * 32 + 8 * fq;
#pragma unroll
        for (int bj = 0; bj < 2; ++bj) { const int c = col0 + bj * HALF;
            f32x4 b0 = (f32x4){0.f, 0.f, 0.f, 0.f}, b1 = b0; if (bias) { b0 = *(const f32x4*)(bias + c); b1 = *(const f32x4*)(bias + c + 4); }
#pragma unroll
            for (int ai = 0; ai < 2; ++ai)
#pragma unroll
                for (int m = 0; m < 4; ++m) { const size_t row = (size_t)(row0 + ai * HALF + m * 16);
                    const u32x4 gw = *(const u32x4*)(Gt + row * 2048 + gcol0 + c);
                    const f32x4 v0 = acc[ai][bj][m][0] + b0, v1 = acc[ai][bj][m][1] + b1;
                    u32x4 w;
                    w.x = cvt_pk_bf16(v0[0] * __uint_as_float(gw.x << 16), v0[1] * __uint_as_float(gw.x & 0xffff0000u));
                    w.y = cvt_pk_bf16(v0[2] * __uint_as_float(gw.y << 16), v0[3] * __uint_as_float(gw.y & 0xffff0000u));
                    w.z = cvt_pk_bf16(v1[0] * __uint_as_float(gw.z << 16), v1[1] * __uint_as_float(gw.z & 0xffff0000u));
                    w.w = cvt_pk_bf16(v1[2] * __uint_as_float(gw.w << 16), v1[3] * __uint_as_float(gw.w & 0xffff0000u));
                    *(u32x4*)(O + row * 2048 + ocol0 + c) = w; } }
    }
};

template <class Epi, class Sched, bool ALIGN_EPI = false, bool SP2 = false>
__device__ __forceinline__ void gemm_phase(PG8_LAS unsigned char* lds, const Gemm g, const Sched& S, const Epi& E) {
    const int tid = threadIdx.x, wid = __builtin_amdgcn_readfirstlane(tid >> 6), lane = tid & 63, wr = wid >> 2, wc = wid & 3, fr = lane & 15, fq = lane >> 4;
    const int K = g.K, nt = K / BK;
    unsigned voffA[2], voffB[2];
#pragma unroll
    for (int i = 0; i < 2; ++i) { int R, C; stage_rc(tid * 16 + i * 8192, R, C); const int Rb = Epi::PERM ? ((R & ~31) + perm32(R & 31)) : R;
        voffA[i] = (unsigned)(R * g.lda + C) * 2u; voffB[i] = (unsigned)(Rb * g.ldb + C) * 2u; }
    const size_t kstep = (size_t)(BK * 2);
    const size_t hstepA = (size_t)HALF * g.lda * 2, hstepB = (size_t)HALF * g.ldb * 2;
    const size_t tstepA = 2 * hstepA, tstepB = 2 * hstepB;
    const unsigned ldsw = (unsigned)wid * 1024u;
    const int aoff = lds_byte(wr * 64 + fr, fq * 8), boff = lds_byte(wc * 32 + fr, fq * 8);
#define PG8_SA(b, h) (((b) * 2 + (h)) * HTB)
#define PG8_SB(b, h) ((4 + (b) * 2 + (h)) * HTB)
#define PG8_STAGE(bufoff, gbase, voff) do { _Pragma("unroll") for (int _i = 0; _i < 2; ++_i) \
        __builtin_amdgcn_global_load_lds((const unsigned*)((const char*)(gbase) + (voff)[_i]), (PG8_LAS unsigned*)(lds + (bufoff) + ldsw + _i * 8192), 16, 0, 0); } while (0)
#define PG8_LDA(dst, b, h) do { _Pragma("unroll") for (int m = 0; m < 4; ++m) _Pragma("unroll") for (int k = 0; k < 2; ++k) dst[m][k] = *(const PG8_LAS bf16x8*)(lds + PG8_SA(b, h) + aoff + m * 2048 + k * 1024); } while (0)
#define PG8_LDB(dst, b, h) do { _Pragma("unroll") for (int n = 0; n < 2; ++n) _Pragma("unroll") for (int k = 0; k < 2; ++k) dst[n][k] = *(const PG8_LAS bf16x8*)(lds + PG8_SB(b, h) + boff + n * 2048 + k * 1024); } while (0)
#define PG8_MMA(ai, bj, At, Bt) do { __builtin_amdgcn_s_setprio(1); _Pragma("unroll") for (int m = 0; m < 4; ++m) _Pragma("unroll") for (int n = 0; n < 2; ++n) _Pragma("unroll") for (int k = 0; k < 2; ++k) \
        acc[ai][bj][m][n] = __builtin_amdgcn_mfma_f32_16x16x32_bf16(Bt[n][k], At[m][k], acc[ai][bj][m][n], 0, 0, 0); __builtin_amdgcn_s_setprio(0); } while (0)
#define PG8_WAIT_V(n) asm volatile("s_waitcnt vmcnt(" #n ")" ::: "memory")
#define PG8_WAIT_L(n) asm volatile("s_waitcnt lgkmcnt(" #n ")" ::: "memory")
#define PG8_BAR __builtin_amdgcn_s_barrier()
#define PG8_SCHED __builtin_amdgcn_sched_barrier(0)
    Unit cur, nxt; int ui = 0;
    if (!S.next(0, cur)) return;
    f32x4 acc[2][2][4][2];
#pragma unroll
    for (int a = 0; a < 2; ++a)
#pragma unroll
        for (int b = 0; b < 2; ++b)
#pragma unroll
            for (int m = 0; m < 4; ++m)
#pragma unroll
                for (int n = 0; n < 2; ++n) acc[a][b][m][n] = (f32x4){0.f, 0.f, 0.f, 0.f};
    bf16x8 At[4][2], B0[2][2], B1[2][2];
    const char* cA = (const char*)g.A + (size_t)cur.pm * tstepA; const char* cB = (const char*)g.Bt + (size_t)cur.pn * tstepB;
    S.a_ready(cur);
    if constexpr (SP2) {
        PG8_STAGE(PG8_SB(0, 0), cB, voffB); PG8_STAGE(PG8_SB(0, 1), cB + hstepB, voffB); PG8_STAGE(PG8_SA(0, 0), cA, voffA); PG8_STAGE(PG8_SA(0, 1), cA + hstepA, voffA);
        if (wr == 1) PG8_BAR;
        PG8_WAIT_V(2); PG8_BAR;
        PG8_STAGE(PG8_SB(1, 0), cB + kstep, voffB); PG8_STAGE(PG8_SA(1, 0), cA + kstep, voffA); PG8_STAGE(PG8_SB(1, 1), cB + hstepB + kstep, voffB);
        PG8_WAIT_V(6); PG8_BAR;
    } else {
        PG8_STAGE(PG8_SB(0, 0), cB, voffB); PG8_STAGE(PG8_SA(0, 0), cA, voffA); PG8_STAGE(PG8_SB(0, 1), cB + hstepB, voffB); PG8_STAGE(PG8_SA(0, 1), cA + hstepA, voffA);
        if (wr == 1) PG8_BAR;
        PG8_WAIT_V(4); PG8_BAR;
        PG8_STAGE(PG8_SB(1, 0), cB + kstep, voffB); PG8_STAGE(PG8_SA(1, 0), cA + kstep, voffA); PG8_STAGE(PG8_SB(1, 1), cB + hstepB + kstep, voffB);
        PG8_WAIT_V(6); PG8_BAR;
    }
    for (;;) {
        const bool has_next = S.next(ui + 1, nxt);
        const char* nA = has_next ? (const char*)g.A + (size_t)nxt.pm * tstepA : cA; const char* nB = has_next ? (const char*)g.Bt + (size_t)nxt.pn * tstepB : cB;
        for (int t = 0; t < nt; t += 2) {
            const bool last = (t == nt - 2);
            const char* a1 = cA + (size_t)(t + 1) * kstep;
            const char* a2 = last ? nA : cA + (size_t)(t + 2) * kstep; const char* b2 = last ? nB : cB + (size_t)(t + 2) * kstep;
            const char* a3 = a2 + kstep; const char* b3 = b2 + kstep;
            if (last && has_next) S.a_ready(nxt);
            if constexpr (SP2) {
            PG8_LDB(B0, 0, 0); PG8_LDB(B1, 0, 1); PG8_SCHED; PG8_LDA(At, 0, 0); PG8_STAGE(PG8_SA(1, 1), a1 + hstepA, voffA);
            PG8_WAIT_V(8); PG8_WAIT_L(0); PG8_BAR; PG8_MMA(0, 0, At, B0); PG8_MMA(0, 1, At, B1); PG8_BAR; PG8_SCHED;
            PG8_LDA(At, 0, 1); PG8_STAGE(PG8_SB(0, 0), b2, voffB); PG8_STAGE(PG8_SB(0, 1), b2 + hstepB, voffB); PG8_STAGE(PG8_SA(0, 0), a2, voffA);
            PG8_WAIT_V(8); PG8_WAIT_L(0); PG8_BAR; PG8_MMA(1, 0, At, B0); PG8_MMA(1, 1, At, B1); PG8_BAR; PG8_SCHED;
            PG8_LDB(B0, 1, 0); PG8_LDB(B1, 1, 1); PG8_SCHED; PG8_LDA(At, 1, 0); PG8_STAGE(PG8_SA(0, 1), a2 + hstepA, voffA);
            PG8_WAIT_V(8); PG8_WAIT_L(0); PG8_BAR; PG8_MMA(0, 0, At, B0); PG8_MMA(0, 1, At, B1); PG8_BAR; PG8_SCHED;
            PG8_LDA(At, 1, 1); PG8_STAGE(PG8_SB(1, 0), b3, voffB); PG8_STAGE(PG8_SB(1, 1), b3 + hstepB, voffB); PG8_STAGE(PG8_SA(1, 0), a3, voffA);
            PG8_WAIT_V(8); PG8_WAIT_L(0); PG8_BAR; PG8_MMA(1, 0, At, B0); PG8_MMA(1, 1, At, B1); PG8_BAR; PG8_SCHED;
            } else {
            PG8_LDB(B0, 0, 0); PG8_SCHED; PG8_LDA(At, 0, 0); PG8_STAGE(PG8_SA(1, 1), a1 + hstepA, voffA);
            PG8_WAIT_L(8); PG8_BAR; PG8_WAIT_L(0); PG8_MMA(0, 0, At, B0); PG8_BAR; PG8_SCHED;
            PG8_LDB(B1, 0, 1); PG8_STAGE(PG8_SB(0, 0), b2, voffB);
            PG8_BAR; PG8_WAIT_L(0); PG8_MMA(0, 1, At, B1); PG8_BAR;
            PG8_LDA(At, 0, 1); PG8_STAGE(PG8_SA(0, 0), a2, voffA);
            PG8_BAR; PG8_WAIT_L(0); PG8_MMA(1, 0, At, B0); PG8_BAR; PG8_SCHED;
            PG8_STAGE(PG8_SB(0, 1), b2 + hstepB, voffB);
            PG8_WAIT_V(6); PG8_BAR; PG8_MMA(1, 1, At, B1); PG8_BAR;
            PG8_LDB(B0, 1, 0); PG8_SCHED; PG8_LDA(At, 1, 0); PG8_STAGE(PG8_SA(0, 1), a2 + hstepA, voffA);
            PG8_WAIT_L(8); PG8_BAR; PG8_WAIT_L(0); PG8_MMA(0, 0, At, B0); PG8_BAR; PG8_SCHED;
            PG8_LDB(B1, 1, 1); PG8_STAGE(PG8_SB(1, 0), b3, voffB);
            PG8_BAR; PG8_WAIT_L(0); PG8_MMA(0, 1, At, B1); PG8_BAR;
            PG8_LDA(At, 1, 1); PG8_STAGE(PG8_SA(1, 0), a3, voffA);
            PG8_BAR; PG8_WAIT_L(0); PG8_MMA(1, 0, At, B0); PG8_BAR; PG8_SCHED;
            PG8_STAGE(PG8_SB(1, 1), b3 + hstepB, voffB);
            PG8_WAIT_V(6); PG8_BAR; PG8_MMA(1, 1, At, B1); PG8_BAR;
            }
        }
        if constexpr (ALIGN_EPI) { if (wr == 0) PG8_BAR; }
        if constexpr (!Epi::AFTER_DRAIN) { E(acc, cur, wr, wc, fr, fq); S.done(cur); }
        if (!has_next) break;
#pragma unroll
        for (int a = 0; a < 2; ++a)
#pragma unroll
            for (int b = 0; b < 2; ++b)
#pragma unroll
                for (int m = 0; m < 4; ++m)
#pragma unroll
                    for (int n = 0; n < 2; ++n) acc[a][b][m][n] = (f32x4){0.f, 0.f, 0.f, 0.f};
        cur = nxt; cA = nA; cB = nB; ++ui;
        if constexpr (ALIGN_EPI) { if (wr == 1) PG8_BAR; }
    }
    PG8_WAIT_V(0);
    if constexpr (!ALIGN_EPI) { if (wr == 0) PG8_BAR; }
    PG8_BAR;
#undef PG8_SA
#undef PG8_SB
#undef PG8_STAGE
#undef PG8_LDA
#undef PG8_LDB
#undef PG8_MMA
#undef PG8_WAIT_V
#undef PG8_WAIT_L
#undef PG8_BAR
#undef PG8_SCHED
}
}

constexpr int NWAVES = 8;
constexpr int BATCH = 8, SEQ = 4096, D = 1024, T = BATCH * SEQ;
constexpr int CONVD = 512, CONVW = 31, SBH = 8, SBD = 64, SBDIM = 512;
constexpr int PH = 8, NKEYS = 128, TOPK = 16, NEXP = NKEYS * NKEYS;
constexpr int NIN = 4096;
constexpr float LN_EPS = 1e-5f;
constexpr float ALPHA = 1.189207115002721f;
constexpr float QSCALE = 0.125f * 1.4426950408889634f;
constexpr int N_PHASES = 12;

constexpr size_t MiB = 1u << 20;
constexpr size_t WS_CTL = 0, CTL_ZERO_BYTES = 1 * MiB;
constexpr size_t WS_WIN = 2 * MiB;
constexpr size_t WS_WV = 10 * MiB;
constexpr size_t WS_WPW2 = 11 * MiB;
constexpr size_t WS_WO = 12 * MiB;
constexpr size_t WS_WOUT = 13 * MiB;
constexpr size_t WS_WEFF = 17 * MiB;
constexpr size_t WS_IDX = 21 * MiB;
constexpr size_t WS_GATE = 37 * MiB;
constexpr size_t WS_UT = 53 * MiB;
constexpr size_t WS_VTAB = 85 * MiB;
constexpr size_t WS_USC = 70 * MiB;
constexpr size_t WS_VSC = 102 * MiB;
constexpr size_t WS_XB = 117 * MiB;
constexpr size_t WS_C = 181 * MiB;
constexpr size_t WS_AO = 213 * MiB;
constexpr size_t WS_GLU = 373 * MiB;
constexpr size_t WS_Q = 405 * MiB;
constexpr size_t WS_K = 437 * MiB;
constexpr size_t WS_VT = 469 * MiB;
constexpr size_t WS_M2 = 373 * MiB;
constexpr size_t WS_G = 245 * MiB;
constexpr size_t WS_R = 245 * MiB;
constexpr size_t WS_ST = 245 * MiB;
constexpr size_t WS_PD = 245 * MiB;
constexpr size_t WS_STATS = 373 * MiB;
constexpr size_t WS_END = 501 * MiB;
constexpr int CW_BAR = 4096;

constexpr int RING_OFF = 0, RING_BYTES = 131072;
constexpr int LDSCTL_OFF = RING_BYTES, MISC_OFF = LDSCTL_OFF + 320;
constexpr int LDS_BYTES = 147456;

#define GAS __attribute__((address_space(1)))
#define LAS __attribute__((address_space(3)))
typedef unsigned short bf16;
typedef unsigned v4u __attribute__((ext_vector_type(4)));
typedef unsigned v2u __attribute__((ext_vector_type(2)));
typedef float f32x4 __attribute__((ext_vector_type(4)));
typedef float f32x16 __attribute__((ext_vector_type(16)));
typedef float f32x2 __attribute__((ext_vector_type(2)));
typedef short bf16x8 __attribute__((ext_vector_type(8)));
typedef GAS unsigned gu32;
#define RLX_AGENT __ATOMIC_RELAXED, __HIP_MEMORY_SCOPE_AGENT
#define LDS_WAIT() asm volatile("s_waitcnt lgkmcnt(0)" ::: "memory")
#define VM_WAIT() asm volatile("s_waitcnt vmcnt(0)" ::: "memory")
__device__ __forceinline__ unsigned f2bf(float f) { unsigned u = __builtin_bit_cast(unsigned, f); return (u + 0x7fffu + ((u >> 16) & 1u)) >> 16; }
__device__ __forceinline__ unsigned pk2(float lo, float hi) { return f2bf(lo) | (f2bf(hi) << 16); }
__device__ __forceinline__ float bflo(unsigned w) { return __uint_as_float(w << 16); }
__device__ __forceinline__ float bfhi(unsigned w) { return __uint_as_float(w & 0xffff0000u); }

#define XB_TMO      128
#define XB_XCNT(j)  (256  + 64 * (j))
#define XB_XSUB(j)  (1280 + 64 * (j))
#define XB_XGEN(j)  (2304 + 64 * (j))
#define XB_TOP      3328
#define XB_TOPGEN   3392
#define XCD_BAR_WORDS 3456
#define XB_SPIN_CAP (1u << 18)
__device__ __forceinline__ unsigned xb_ld(unsigned* p)              { return __hip_atomic_load(p, __ATOMIC_RELAXED, __HIP_MEMORY_SCOPE_AGENT); }
__device__ __forceinline__ unsigned xb_add(unsigned* p, unsigned v) { return __hip_atomic_fetch_add(p, v, __ATOMIC_RELAXED, __HIP_MEMORY_SCOPE_AGENT); }
__device__ __forceinline__ unsigned xb_xcc_id() { return (unsigned)__builtin_amdgcn_s_getreg((3 << 11) | 20) & 0xFu; }
#define XB_SPIN(cond, bar) do { unsigned _sp = 0; while (cond) { __builtin_amdgcn_s_sleep(1); \
    if ((++_sp & 255u) == 0u) { if (xb_ld(&(bar)[XB_TMO])) break; if (_sp > XB_SPIN_CAP) { atomicAdd(&(bar)[XB_TMO], 1u); break; } } } } while (0)
struct XcdBarrier { unsigned* bar; unsigned x; volatile LAS unsigned* st; };
__device__ __forceinline__ XcdBarrier xcd_barrier_post(unsigned* bar, volatile LAS unsigned* st) {
    XcdBarrier b; b.bar = bar; b.x = xb_xcc_id(); b.st = st;
    if (threadIdx.x == 0) (void)xb_add(&bar[XB_XCNT(b.x)], 1u);
    return b;
}
__device__ __forceinline__ void xcd_barrier_complete(unsigned* bar, unsigned x, unsigned& nloc, unsigned& nx) {
    const unsigned G = gridDim.x * gridDim.y * gridDim.z;
    unsigned sum, cnt, mine, sp = 0u;
    for (;;) {
        sum = 0u; cnt = 0u; mine = 0u;
#pragma unroll
        for (unsigned j = 0; j < 16; ++j) { const unsigned c = xb_ld(&bar[XB_XCNT(j)]); sum += c; cnt += (c > 0u) ? 1u : 0u; mine = (j == x) ? c : mine; }
        if (sum == G) break;
        __builtin_amdgcn_s_sleep(1);
        if ((++sp & 255u) == 0u) { if (xb_ld(&bar[XB_TMO])) break; if (sp > XB_SPIN_CAP) { atomicAdd(&bar[XB_TMO], 1u); break; } }
    }
    nloc = mine > 0u ? mine : 1u; nx = cnt > 0u ? cnt : 1u;
}
__device__ __forceinline__ void xcd_barrier(const XcdBarrier& b) {
    asm volatile("s_waitcnt vmcnt(0)" ::: "memory");
    __syncthreads();
    if (threadIdx.x == 0) {
        unsigned* bar = b.bar;
        __builtin_amdgcn_s_waitcnt(0);
        unsigned nloc = b.st[0], nx = b.st[1];
        if (nloc == 0u) { xcd_barrier_complete(bar, b.x, nloc, nx); b.st[0] = nloc; b.st[1] = nx; }
        const unsigned old = xb_add(&bar[XB_XSUB(b.x)], 1u);
        const unsigned gen = old / nloc;
        if (old + 1u == (gen + 1u) * nloc) {
            __builtin_amdgcn_fence(__ATOMIC_RELEASE, "agent");
            asm volatile("s_waitcnt vmcnt(0)" ::: "memory");
            const unsigned og = xb_add(&bar[XB_TOP], 1u);
            const unsigned tg = og / nx;
            if (og + 1u == (tg + 1u) * nx) xb_add(&bar[XB_TOPGEN], 1u);
            else XB_SPIN(xb_ld(&bar[XB_TOPGEN]) == tg, bar);
            __builtin_amdgcn_fence(__ATOMIC_ACQUIRE, "agent");
            xb_add(&bar[XB_XGEN(b.x)], 1u);
            asm volatile("s_waitcnt vmcnt(0)" ::: "memory");
        } else {
            XB_SPIN(xb_ld(&bar[XB_XGEN(b.x)]) == gen, bar);
            __builtin_amdgcn_fence(__ATOMIC_ACQUIRE, "agent");
            asm volatile("s_waitcnt vmcnt(0)" ::: "memory");
        }
    }
    __syncthreads();
}

struct Frame {
    LAS unsigned char* lds;
    volatile LAS unsigned* MISC;
    gu32* ctl;
    int tid, lane, wave;
    int vcu, G;
    const float *x, *w_in, *b_in, *cw_dw, *cb_dw, *cln_g, *cln_b, *w_pw2, *b_pw2, *w_o, *w_out, *b_out, *ln1_g, *ln1_b, *w_q, *keys1, *keys2, *pu, *pv, *ln2_g, *ln2_b;
    float* out;
    unsigned char *UT, *VTAB; float *USC, *VSC;
    bf16 *WinT, *WvT, *Wpw2T, *WoT, *WoutT, *WeffT, *XB, *Cb, *AO, *GLU, *Qb, *Kb, *VT, *M2, *Gt;
    float *R, *ST, *GATE, *PD, *STATS; int* IDX;
};

__device__ __forceinline__ float wave_sum(float v) {
#pragma unroll
    for (int o = 1; o < 64; o <<= 1) v += __shfl_xor(v, o);
    return v;
}

__device__ __forceinline__ void p0_transpose_item(const float* W, int ldw, int src_col0, int k0, bf16* WT, int ldt, int dst_row0, int dst_k0, LAS float* scr, int lane) {
#pragma unroll 8
    for (int i = 0; i < 32; ++i) { const int kk = 2 * i + (lane >> 5); scr[kk * 33 + (lane & 31)] = W[(size_t)(k0 + kk) * ldw + src_col0 + (lane & 31)]; }
    LDS_WAIT(); asm volatile("" ::: "memory");
    const int c = lane & 7;
#pragma unroll
    for (int j = 0; j < 4; ++j) { const int n = (lane >> 3) + 8 * j; const LAS float* s = scr + (8 * c) * 33 + n;
        v4u o; o.x = pk2(s[0 * 33], s[1 * 33]); o.y = pk2(s[2 * 33], s[3 * 33]); o.z = pk2(s[4 * 33], s[5 * 33]); o.w = pk2(s[6 * 33], s[7 * 33]);
        *(GAS v4u*)(WT + (size_t)(dst_row0 + n) * ldt + dst_k0 + 8 * c) = o; }
    LDS_WAIT(); asm volatile("" ::: "memory");
}
__device__ __forceinline__ void p0_convert(const float* src, bf16* dst, size_t n8, int gw, int NGW, int lane) {
    for (size_t i = (size_t)gw * 64 + lane; i < n8; i += (size_t)NGW * 64) {
        const f32x4 a = *(const GAS f32x4*)(src + i * 8), b = *(const GAS f32x4*)(src + i * 8 + 4);
        v4u o; o.x = pk2(a.x, a.y); o.y = pk2(a.z, a.w); o.z = pk2(b.x, b.y); o.w = pk2(b.z, b.w);
        *(GAS v4u*)(dst + i * 8) = o; }
}
__device__ __forceinline__ float wave_max(float v) {
#pragma unroll
    for (int o = 1; o < 64; o <<= 1) v = fmaxf(v, __shfl_xor(v, o));
    return v;
}
__device__ __forceinline__ void p0_row_fp8(const float* src, unsigned char* dst, float* inv_scale, int lane) {
    f32x4 v[4]; float m = 0.f;
#pragma unroll
    for (int j = 0; j < 4; ++j) { v[j] = *(const GAS f32x4*)(src + 16 * lane + 4 * j); m = fmaxf(m, fmaxf(fmaxf(fabsf(v[j].x), fabsf(v[j].y)), fmaxf(fabsf(v[j].z), fabsf(v[j].w)))); }
    m = wave_max(m);
    const float sc = m > 0.f ? 256.0f / m : 1.0f;
    v4u o; unsigned w;
    w = 0u; w = __builtin_amdgcn_cvt_pk_fp8_f32(v[0].x * sc, v[0].y * sc, w, false); w = __builtin_amdgcn_cvt_pk_fp8_f32(v[0].z * sc, v[0].w * sc, w, true); o.x = w;
    w = 0u; w = __builtin_amdgcn_cvt_pk_fp8_f32(v[1].x * sc, v[1].y * sc, w, false); w = __builtin_amdgcn_cvt_pk_fp8_f32(v[1].z * sc, v[1].w * sc, w, true); o.y = w;
    w = 0u; w = __builtin_amdgcn_cvt_pk_fp8_f32(v[2].x * sc, v[2].y * sc, w, false); w = __builtin_amdgcn_cvt_pk_fp8_f32(v[2].z * sc, v[2].w * sc, w, true); o.z = w;
    w = 0u; w = __builtin_amdgcn_cvt_pk_fp8_f32(v[3].x * sc, v[3].y * sc, w, false); w = __builtin_amdgcn_cvt_pk_fp8_f32(v[3].z * sc, v[3].w * sc, w, true); o.w = w;
    *(GAS v4u*)(dst + ((size_t)(lane >> 3) << 21) + 16 * (lane & 7)) = o;
    if (lane == 0) *inv_scale = m > 0.f ? m * (1.0f / 256.0f) : 1.0f;
}
__device__ __forceinline__ void p0_weff_tile(Frame& F, int tile) {
    const int lane = F.lane, r32 = lane & 31, hi = lane >> 5;
    const int it = tile & 31, kt = (tile >> 5) & 3, g = tile >> 7;
    const int h = g >> 1, half = g & 1;
    const float* kp = (half ? F.keys2 : F.keys1) + ((size_t)h * NKEYS + kt * 32 + r32) * 128 + 64 * hi;
    const float* wp = F.w_q + (size_t)(it * 32 + r32) * 2048 + g * 128 + 64 * hi;
    f32x4 a[16], b[16];
#pragma unroll
    for (int j = 0; j < 16; ++j) { a[j] = *(const GAS f32x4*)(kp + 4 * j); b[j] = *(const GAS f32x4*)(wp + 4 * j); }
    f32x16 c = {};
#pragma unroll
    for (int j = 0; j < 16; ++j)
#pragma unroll
        for (int e = 0; e < 4; ++e) c = __builtin_amdgcn_mfma_f32_32x32x2f32(a[j][e], b[j][e], c, 0, 0, 0);
#pragma unroll
    for (int r = 0; r < 16; ++r) { const int row = (r & 3) + 8 * (r >> 2) + 4 * hi;
        F.WeffT[(size_t)(g * 128 + kt * 32 + row) * 1024 + it * 32 + r32] = (bf16)f2bf(c[r]); }
}
__device__ __forceinline__ void p0_prologue(Frame& F) {
    LAS float* scr = (LAS float*)(F.lds + RING_OFF + F.wave * 16384);
    const int gw = F.vcu * NWAVES + F.wave, NGW = F.G * NWAVES;
    constexpr int I_IN = 16 * 128, I_V = 16 * 16, I_P = 8 * 32, I_O = 8 * 32, I_W = 16 * 32;
    constexpr int NITEMS = I_IN + I_V + I_P + I_O + I_W;
    for (int itx = gw; itx < NITEMS; itx += NGW) {
        int r = itx;
        if (r < I_IN) { const int kb = r / 128, nb = r % 128, j0 = nb * 32;
            int oc; if (j0 < 1024) { const int pn = j0 >> 8, w = j0 & 255; oc = (w < 128) ? pn * 128 + w : 512 + pn * 128 + (w - 128); } else if (j0 < 2048) oc = j0; else oc = j0 + 512;
            p0_transpose_item(F.w_in, 4608, oc, kb * 64, F.WinT, 1024, j0, kb * 64, scr, F.lane); continue; } r -= I_IN;
        if (r < I_V) { const int kb = r / 16, nb = r % 16; p0_transpose_item(F.w_in, 4608, 2048 + nb * 32, kb * 64, F.WvT, 1024, nb * 32, kb * 64, scr, F.lane); continue; } r -= I_V;
        if (r < I_P) { const int kb = r / 32, nb = r % 32; p0_transpose_item(F.w_pw2, 1024, nb * 32, kb * 64, F.Wpw2T, 512, nb * 32, kb * 64, scr, F.lane); continue; } r -= I_P;
        if (r < I_O) { const int kb = r / 32, nb = r % 32; p0_transpose_item(F.w_o, 1024, nb * 32, kb * 64, F.WoT, 512, nb * 32, kb * 64, scr, F.lane); continue; } r -= I_O;
        { const int kb = r / 32, nb = r % 32; p0_transpose_item(F.w_out, 1024, nb * 32, kb * 64, F.WoutT, 2048, nb * 32, kb * 64, scr, F.lane);
          p0_transpose_item(F.w_out, 1024, nb * 32, kb * 64, F.WoutT, 2048, nb * 32, 1024 + kb * 64, scr, F.lane); }
    }
    for (int tile = gw; tile < 2048; tile += NGW) p0_weff_tile(F, tile);
    p0_convert(F.x, F.XB, (size_t)T * D / 8, gw, NGW, F.lane);
    for (int r = gw; r < 2 * NEXP; r += NGW) { if (r < NEXP) p0_row_fp8(F.pu + (size_t)r * D, F.UT + (size_t)r * 128, F.USC + r, F.lane); else p0_row_fp8(F.pv + (size_t)(r - NEXP) * D, F.VTAB + (size_t)(r - NEXP) * 128, F.VSC + (r - NEXP), F.lane); }
}

__device__ __forceinline__ void conv_unit(Frame& F, int ct) {
    const int tid = F.tid, lane = F.lane, w = F.wave;
    const int tb = ct * 64, p0 = tb & (SEQ - 1);
    LAS unsigned char* L = F.lds + RING_OFF;
    for (int c = tid; c < 94 * 64; c += NWAVES * 64) { const int r = c >> 6, ch = c & 63; v4u v = (v4u){0u, 0u, 0u, 0u};
        if (p0 - 30 + r >= 0) v = *(const GAS v4u*)(F.GLU + (size_t)(tb - 30 + r) * CONVD + ch * 8);
        *(LAS v4u*)(L + r * 1024 + ch * 16) = v; }
    __syncthreads();
    float s1[8], s2[8];
#pragma unroll
    for (int i = 0; i < 8; ++i) { s1[i] = 0.f; s2[i] = 0.f; }
#define CONV_BODY() \
        const int p = lane + 64 * q, c0 = 2 * p; \
        const f32x2 bb = *(const GAS f32x2*)(F.cb_dw + c0); \
        float a0[8], a1[8]; \
        _Pragma("unroll") for (int i = 0; i < 8; ++i) { a0[i] = bb.x; a1[i] = bb.y; } \
        float w0[CONVW], w1[CONVW]; \
        _Pragma("unroll") for (int rr = 0; rr < 38; ++rr) { \
            if (rr < CONVW) { const f32x2 ww = *(const GAS f32x2*)(F.cw_dw + rr * CONVD + c0); w0[rr] = ww.x; w1[rr] = ww.y; } \
            const unsigned g2 = *(const LAS unsigned*)(L + (8 * w + rr) * 1024 + p * 4); \
            const float lo = bflo(g2), hi = bfhi(g2); \
            _Pragma("unroll") for (int i = 0; i < 8; ++i) { const int j = rr - i; if (j >= 0 && j < CONVW) { a0[i] += w0[j] * lo; a1[i] += w1[j] * hi; } } \
        }
#pragma unroll 1
    for (int q = 0; q < 4; ++q) {
        CONV_BODY()
#pragma unroll
        for (int i = 0; i < 8; ++i) { s1[i] += a0[i] + a1[i]; s2[i] += a0[i] * a0[i] + a1[i] * a1[i]; }
    }
    float mean[8], rstd[8];
#pragma unroll
    for (int i = 0; i < 8; ++i) { mean[i] = wave_sum(s1[i]) * (1.0f / CONVD); const float var = wave_sum(s2[i]) * (1.0f / CONVD) - mean[i] * mean[i];
        rstd[i] = 1.0f / sqrtf(fmaxf(var, 0.f) + LN_EPS); }
#pragma unroll 1
    for (int q = 0; q < 4; ++q) {
        CONV_BODY()
        const f32x2 gg = *(const GAS f32x2*)(F.cln_g + c0), lb = *(const GAS f32x2*)(F.cln_b + c0);
#pragma unroll
        for (int i = 0; i < 8; ++i) { float v0 = (a0[i] - mean[i]) * rstd[i] * gg.x + lb.x, v1 = (a1[i] - mean[i]) * rstd[i] * gg.y + lb.y;
            v0 = v0 * pg8::sigmoid_f(v0); v1 = v1 * pg8::sigmoid_f(v1);
            *(GAS unsigned*)(F.Cb + (size_t)(tb + 8 * w + i) * CONVD + c0) = pk2(v0, v1); }
    }
#undef CONV_BODY
    __syncthreads();
}

__device__ __forceinline__ unsigned cvtpk_s(float lo, float hi) { typedef float f2 __attribute__((ext_vector_type(2))); typedef __bf16 b2 __attribute__((ext_vector_type(2))); f2 v = {lo, hi}; b2 b = __builtin_convertvector(v, b2); return __builtin_bit_cast(unsigned, b); }
__device__ __forceinline__ void attn_task(Frame& F, int task) {
    const int lane = F.lane, r32 = lane & 31, hi = lane >> 5;
    const int qblk = task & 127, h = (task >> 7) & 7, b = task >> 10;
    const int q0 = qblk * 32; const size_t rowbase = (size_t)b * SEQ;
    bf16x8 qf[4];
#pragma unroll
    for (int d0 = 0; d0 < 4; ++d0) qf[d0] = *(const GAS bf16x8*)(F.Qb + (rowbase + q0 + r32) * SBDIM + h * SBD + d0 * 16 + hi * 8);
    f32x16 o0 = {}, o1 = {};
    float Rc = 1.0f;
    const int kperm = 32 * ((r32 >> 2) & 1) + 4 * (r32 >> 3) + (r32 & 3);
    const int jt0 = q0 >> 6;
    const int qpos = q0 + r32;
    for (int jt = jt0; jt >= 0; --jt) {
        const int t0 = jt * 64;
        bf16x8 kf[2][4];
#pragma unroll
        for (int p = 0; p < 2; ++p)
#pragma unroll
            for (int d0 = 0; d0 < 4; ++d0) kf[p][d0] = *(const GAS bf16x8*)(F.Kb + (rowbase + t0 + kperm + 16 * p) * SBDIM + h * SBD + d0 * 16 + hi * 8);
        bf16x8 vf[2][2][2];
#pragma unroll
        for (int dt = 0; dt < 2; ++dt)
#pragma unroll
            for (int p = 0; p < 2; ++p)
#pragma unroll
                for (int s = 0; s < 2; ++s) vf[dt][p][s] = *(const GAS bf16x8*)(F.VT + (size_t)(h * SBD + dt * 32 + r32) * T + rowbase + t0 + 32 * hi + 16 * p + 8 * s);
        f32x16 sp[2];
#pragma unroll
        for (int p = 0; p < 2; ++p) { sp[p] = (f32x16){};
#pragma unroll
            for (int d0 = 0; d0 < 4; ++d0) sp[p] = __builtin_amdgcn_mfma_f32_32x32x16_bf16(kf[p][d0], qf[d0], sp[p], 0, 0, 0); }
        float rr[32], be[32];
#pragma unroll
        for (int p = 0; p < 2; ++p)
#pragma unroll
            for (int r = 0; r < 16; ++r) { const float e = __builtin_amdgcn_exp2f(sp[p][r]); const float om = __builtin_amdgcn_rcpf(1.0f + e); rr[16 * p + r] = om; be[16 * p + r] = 1.0f - om; }
        if (jt == jt0) {
#pragma unroll
            for (int i = 0; i < 32; ++i) { const bool valid = (t0 + 32 * hi + i) < qpos; rr[i] = valid ? rr[i] : 1.0f; be[i] = valid ? be[i] : 0.0f; }
        }
        float tt[16];
#pragma unroll
        for (int i = 0; i < 16; ++i) tt[i] = rr[2 * i] * rr[2 * i + 1];
#pragma unroll
        for (int i = 0; i < 8; ++i) tt[i] = tt[2 * i] * tt[2 * i + 1];
#pragma unroll
        for (int i = 0; i < 4; ++i) tt[i] = tt[2 * i] * tt[2 * i + 1];
        const float tot = (tt[0] * tt[1]) * (tt[2] * tt[3]);
        const float oth = __shfl_xor(tot, 32);
        float run = hi ? Rc : Rc * oth;
        Rc = Rc * tot * oth;
        float pa[32];
#pragma unroll
        for (int i = 31; i >= 0; --i) { pa[i] = be[i] * run; run *= rr[i]; }
#pragma unroll
        for (int p = 0; p < 2; ++p)
#pragma unroll
            for (int s = 0; s < 2; ++s) { v4u pw; const int bs = 16 * p + 8 * s;
                pw.x = cvtpk_s(pa[bs], pa[bs + 1]); pw.y = cvtpk_s(pa[bs + 2], pa[bs + 3]); pw.z = cvtpk_s(pa[bs + 4], pa[bs + 5]); pw.w = cvtpk_s(pa[bs + 6], pa[bs + 7]);
                const bf16x8 pf = __builtin_bit_cast(bf16x8, pw);
                o0 = __builtin_amdgcn_mfma_f32_32x32x16_bf16(pf, vf[0][p][s], o0, 0, 0, 0);
                o1 = __builtin_amdgcn_mfma_f32_32x32x16_bf16(pf, vf[1][p][s], o1, 0, 0, 0); }
        if (__all(Rc < 1e-12f)) break;
    }
#pragma unroll
    for (int r = 0; r < 16; ++r) { const int q = (r & 3) + 8 * (r >> 2) + 4 * hi; bf16* op = F.AO + (rowbase + q0 + q) * SBDIM + h * SBD + r32;
        op[0] = (bf16)f2bf(o0[r]); op[32] = (bf16)f2bf(o1[r]); }
}

__device__ __forceinline__ void ln1_row(Frame& F, int m) {
    const GAS f32x4* xr = (const GAS f32x4*)(F.R + (size_t)m * D) + F.lane;
    f32x4 v[4]; float s = 0.f;
#pragma unroll
    for (int j = 0; j < 4; ++j) { v[j] = xr[64 * j]; s += (v[j].x + v[j].y) + (v[j].z + v[j].w); }
    const float mean = wave_sum(s) * (1.f / D); float s2 = 0.f;
#pragma unroll
    for (int j = 0; j < 4; ++j) { v[j] = v[j] - mean; s2 += (v[j].x * v[j].x + v[j].y * v[j].y) + (v[j].z * v[j].z + v[j].w * v[j].w); }
    const float rstd = 1.f / sqrtf(wave_sum(s2) * (1.f / D) + LN_EPS);
    GAS v2u* o8 = (GAS v2u*)(F.XB + (size_t)m * D) + F.lane;
#pragma unroll
    for (int j = 0; j < 4; ++j) { const f32x4 gg = *((const GAS f32x4*)F.ln1_g + F.lane + 64 * j), bb = *((const GAS f32x4*)F.ln1_b + F.lane + 64 * j);
        const f32x4 y = v[j] * rstd * gg + bb; v2u o; o.x = pk2(y.x, y.y); o.y = pk2(y.z, y.w); o8[64 * j] = o; }
}

#define CE_DESC(a, b) do { const unsigned _x = (a), _y = (b); (a) = _x > _y ? _x : _y; (b) = _x > _y ? _y : _x; } while (0)
__device__ __forceinline__ unsigned f2key(float f) { const unsigned u = __float_as_uint(f); return (u & 0x80000000u) ? ~u : (u | 0x80000000u); }
__device__ __forceinline__ float key2f(unsigned k) { const unsigned u = (k & 0x80000000u) ? (k & 0x7fffffffu) : ~k; return __uint_as_float(u); }
__device__ __forceinline__ void sort16_desc(unsigned (&a)[16]) {
#pragma unroll
    for (int k = 2; k <= 16; k <<= 1)
#pragma unroll
        for (int j = k >> 1; j > 0; j >>= 1)
#pragma unroll
            for (int i = 0; i < 16; ++i) { const int l = i ^ j; if (l > i) { if ((i & k) == 0) CE_DESC(a[i], a[l]); else CE_DESC(a[l], a[i]); } }
}
__device__ __forceinline__ void merge16_desc(unsigned (&t)[16], const unsigned (&c)[16]) {
#pragma unroll
    for (int i = 0; i < 16; ++i) t[i] = t[i] > c[15 - i] ? t[i] : c[15 - i];
#pragma unroll
    for (int j = 8; j > 0; j >>= 1)
#pragma unroll
        for (int i = 0; i < 16; ++i) { const int l = i ^ j; if (l > i) CE_DESC(t[i], t[l]); }
}
__device__ __forceinline__ void top16_of_128(const float* col, unsigned (&top)[16]) {
#pragma unroll 1
    for (int c = 0; c < 8; ++c) {
        unsigned a[16];
#pragma unroll
        for (int i = 0; i < 16; ++i) { const float v = *(const GAS float*)(col + (size_t)(c * 16 + i) * T); a[i] = (f2key(v) & ~127u) | (unsigned)(127 - (c * 16 + i)); }
        sort16_desc(a);
        if (c == 0) {
#pragma unroll
            for (int i = 0; i < 16; ++i) top[i] = a[i];
        } else merge16_desc(top, a);
    }
}
__device__ __forceinline__ void select_task(Frame& F, int task) {
    const int lane = F.lane, w = F.wave;
    const int h = task & 7, tblk = task >> 3; const int t = tblk * 64 + lane;
    unsigned v1[16], v2[16];
    top16_of_128(F.ST + (size_t)(h * 256) * T + t, v1);
    top16_of_128(F.ST + (size_t)(h * 256 + 128) * T + t, v2);
    LAS unsigned* L = (LAS unsigned*)(F.lds + RING_OFF) + w * 2048;
#pragma unroll
    for (int i = 0; i < 16; ++i) { L[i * 64 + lane] = v1[i]; L[(16 + i) * 64 + lane] = v2[i]; }
    float f1[16], f2[16];
#pragma unroll
    for (int i = 0; i < 16; ++i) { f1[i] = key2f(v1[i] & ~127u); f2[i] = key2f(v2[i] & ~127u); }
    unsigned top[16], cg[16];
#define CAND(i, j) ((f2key(f1[i] + f2[j]) & ~255u) | (unsigned)((i) * 16 + (j)))
#pragma unroll
    for (int j = 0; j < 16; ++j) top[j] = CAND(0, j);
    sort16_desc(top);
#pragma unroll
    for (int j = 0; j < 8; ++j) { cg[j] = CAND(1, j); cg[8 + j] = CAND(8 + j, 0); }
    sort16_desc(cg); merge16_desc(top, cg);
    cg[0] = CAND(2, 0); cg[1] = CAND(2, 1); cg[2] = CAND(2, 2); cg[3] = CAND(2, 3); cg[4] = CAND(2, 4);
    cg[5] = CAND(3, 0); cg[6] = CAND(3, 1); cg[7] = CAND(3, 2); cg[8] = CAND(3, 3);
    cg[9] = CAND(4, 0); cg[10] = CAND(4, 1); cg[11] = CAND(4, 2);
    cg[12] = CAND(5, 0); cg[13] = CAND(5, 1); cg[14] = CAND(6, 0); cg[15] = CAND(6, 1);
    sort16_desc(cg); merge16_desc(top, cg);
    cg[0] = CAND(7, 0); cg[1] = CAND(7, 1);
#pragma unroll
    for (int j = 2; j < 16; ++j) cg[j] = 0u;
    sort16_desc(cg); merge16_desc(top, cg);
#undef CAND
    LDS_WAIT(); asm volatile("" ::: "memory");
    float sv[16]; int ex[16];
#pragma unroll
    for (int j = 0; j < 16; ++j) { const unsigned k = top[j]; const int ci = (k >> 4) & 15, cj = k & 15;
        sv[j] = key2f(k & ~255u);
        const unsigned a = L[ci * 64 + lane], bq = L[(16 + cj) * 64 + lane];
        ex[j] = (127 - (int)(a & 127u)) * NKEYS + (127 - (int)(bq & 127u)); }
    float mx = sv[0], sum = 0.f;
#pragma unroll
    for (int j = 0; j < 16; ++j) { sv[j] = __builtin_amdgcn_exp2f((sv[j] - mx) * 1.4426950408889634f); sum += sv[j]; }
    const float inv = 1.0f / sum;
    GAS v4u* ip = (GAS v4u*)(F.IDX + (size_t)t * 128 + h * 16); GAS f32x4* gp = (GAS f32x4*)(F.GATE + (size_t)t * 128 + h * 16);
#pragma unroll
    for (int j = 0; j < 4; ++j) { ip[j] = (v4u){(unsigned)ex[4 * j], (unsigned)ex[4 * j + 1], (unsigned)ex[4 * j + 2], (unsigned)ex[4 * j + 3]};
        gp[j] = (f32x4){sv[4 * j] * inv, sv[4 * j + 1] * inv, sv[4 * j + 2] * inv, sv[4 * j + 3] * inv}; }
    LDS_WAIT(); asm volatile("" ::: "memory");
}

__device__ __forceinline__ float dot2bf(unsigned a, unsigned b, float acc) {
    typedef __bf16 b2 __attribute__((ext_vector_type(2)));
    return __builtin_amdgcn_fdot2_f32_bf16(__builtin_bit_cast(b2, a), __builtin_bit_cast(b2, b), acc, false);
}
__device__ __forceinline__ float gelu_erf(float v) {
    const float av = fabsf(v), t = __builtin_amdgcn_rcpf(av * 0.2316418882f + 1.0f);
    float q = t * 0.5307027145f + (-0.7265760135f); q = q * t + 0.7107068705f; q = q * t + (-0.142248368f); q = q * t + 0.127414796f; q = q * t;
    const float e = __builtin_amdgcn_exp2f((v * v) * (-0.72134752044f));
    const float m = v * (q * e);
    return v < 0.f ? m : v - m;
}
#define DPPF(v, ctrl) __builtin_bit_cast(float, __builtin_amdgcn_update_dpp(0, __builtin_bit_cast(int, (v)), (ctrl), 0xF, 0xF, true))
__device__ __forceinline__ float row16_sum(float v) {
    v += DPPF(v, 0xB1); v += DPPF(v, 0x4E); v += DPPF(v, 0x141); v += DPPF(v, 0x140); return v;
}
__device__ __forceinline__ float xgroup_sum(float v) {
    { auto r = __builtin_amdgcn_permlane16_swap(__float_as_uint(v), __float_as_uint(v), false, false); v = __uint_as_float(r[0]) + __uint_as_float(r[1]); }
    { auto r = __builtin_amdgcn_permlane32_swap(__float_as_uint(v), __float_as_uint(v), false, false); v = __uint_as_float(r[0]) + __uint_as_float(r[1]); }
    return v;
}
__device__ __forceinline__ float row8_sum(float v) {
    v += DPPF(v, 0xB1); v += DPPF(v, 0x4E); v += DPPF(v, 0x141); return v;
}
__device__ __forceinline__ float col8_sum(float v) {
    v += DPPF(v, 0x128);
    { auto r = __builtin_amdgcn_permlane16_swap(__float_as_uint(v), __float_as_uint(v), false, false); v = __uint_as_float(r[0]) + __uint_as_float(r[1]); }
    { auto r = __builtin_amdgcn_permlane32_swap(__float_as_uint(v), __float_as_uint(v), false, false); v = __uint_as_float(r[0]) + __uint_as_float(r[1]); }
    return v;
}
template <bool VPH>
__device__ __forceinline__ void peer_slice_phase(Frame& F) {
    const int lane = F.lane, r8 = lane >> 3, c8 = lane & 7;
    const int sl = (int)blockIdx.x & 7, rank = (int)blockIdx.x >> 3, nr = F.G >> 3;
    LAS int* Lidx = (LAS int*)(F.lds + RING_OFF + F.wave * 4096);
    LAS float* Lco = (LAS float*)(Lidx + 256);
    const unsigned char* tab = (VPH ? F.VTAB : F.UT) + ((size_t)sl << 21) + c8 * 16;
    const int tstride = nr * 8;
    int t = rank * 8 + F.wave;
    if (t >= T) return;
    v4u bufA[16], bufB[16]; v4u xA[2], xB[2]; int i0, i1; float g0 = 0.f, g1 = 0.f;
#define S_LOAD_IDX(tt) do { i0 = F.IDX[(size_t)(tt) * 128 + lane]; i1 = F.IDX[(size_t)(tt) * 128 + 64 + lane]; if (VPH) { g0 = F.GATE[(size_t)(tt) * 128 + lane]; g1 = F.GATE[(size_t)(tt) * 128 + 64 + lane]; } } while (0)
#define S_PUT_IDX(slot) do { Lidx[(slot) * 128 + lane] = i0; Lidx[(slot) * 128 + 64 + lane] = i1; if (VPH) { Lco[(slot) * 128 + lane] = g0; Lco[(slot) * 128 + 64 + lane] = g1; } LDS_WAIT(); asm volatile("" ::: "memory"); } while (0)
#define S_ISSUE(buf, xb, slot, tt) do { \
        _Pragma("unroll") for (int it = 0; it < 16; ++it) { const int e_ = Lidx[(slot) * 128 + it * 8 + r8]; buf[it] = *(const GAS v4u*)(tab + ((size_t)e_ << 7)); } \
        const GAS v4u* xp_ = (const GAS v4u*)(F.XB + (size_t)(tt) * D + sl * 128 + c8 * 16); xb[0] = xp_[0]; xb[1] = xp_[1]; } while (0)
#define S_CVT16(W_, f) do { const f32x2 q0_ = __builtin_amdgcn_cvt_pk_f32_fp8((W_).x, false), q1_ = __builtin_amdgcn_cvt_pk_f32_fp8((W_).x, true), q2_ = __builtin_amdgcn_cvt_pk_f32_fp8((W_).y, false), q3_ = __builtin_amdgcn_cvt_pk_f32_fp8((W_).y, true); \
        const f32x2 q4_ = __builtin_amdgcn_cvt_pk_f32_fp8((W_).z, false), q5_ = __builtin_amdgcn_cvt_pk_f32_fp8((W_).z, true), q6_ = __builtin_amdgcn_cvt_pk_f32_fp8((W_).w, false), q7_ = __builtin_amdgcn_cvt_pk_f32_fp8((W_).w, true); \
        f[0] = q0_.x; f[1] = q0_.y; f[2] = q1_.x; f[3] = q1_.y; f[4] = q2_.x; f[5] = q2_.y; f[6] = q3_.x; f[7] = q3_.y; f[8] = q4_.x; f[9] = q4_.y; f[10] = q5_.x; f[11] = q5_.y; f[12] = q6_.x; f[13] = q6_.y; f[14] = q7_.x; f[15] = q7_.y; } while (0)
#define S_XF(xb, xf) do { xf[0] = bflo(xb[0].x); xf[1] = bfhi(xb[0].x); xf[2] = bflo(xb[0].y); xf[3] = bfhi(xb[0].y); xf[4] = bflo(xb[0].z); xf[5] = bfhi(xb[0].z); xf[6] = bflo(xb[0].w); xf[7] = bfhi(xb[0].w); \
        xf[8] = bflo(xb[1].x); xf[9] = bfhi(xb[1].x); xf[10] = bflo(xb[1].y); xf[11] = bfhi(xb[1].y); xf[12] = bflo(xb[1].z); xf[13] = bfhi(xb[1].z); xf[14] = bflo(xb[1].w); xf[15] = bfhi(xb[1].w); } while (0)
#define S_COMPUTE(buf, xb, slot, tt) do { float xf[16]; S_XF(xb, xf); \
        if (!VPH) { \
            _Pragma("unroll") for (int it = 0; it < 16; ++it) { float f[16]; S_CVT16(buf[it], f); float d_ = 0.f; \
                _Pragma("unroll") for (int k = 0; k < 16; ++k) d_ += f[k] * xf[k]; \
                d_ = row8_sum(d_); if (c8 == 0) Lco[it * 8 + r8] = d_; } \
            LDS_WAIT(); asm volatile("" ::: "memory"); \
            const float d0_ = Lco[lane], d1_ = Lco[lane + 64]; \
            GAS float* pd_ = (GAS float*)(F.PD + ((size_t)(tt) * 8 + sl) * 128); pd_[lane] = d0_; pd_[lane + 64] = d1_; \
            LDS_WAIT(); asm volatile("" ::: "memory"); \
        } else { \
            float acc[16]; \
            _Pragma("unroll") for (int k = 0; k < 16; ++k) acc[k] = 0.f; \
            _Pragma("unroll") for (int it = 0; it < 16; ++it) { float f[16]; S_CVT16(buf[it], f); const float cf_ = Lco[(slot) * 128 + it * 8 + r8]; \
                _Pragma("unroll") for (int k = 0; k < 16; ++k) acc[k] += cf_ * f[k]; } \
            float s1_ = 0.f, s2_ = 0.f; \
            _Pragma("unroll") for (int k = 0; k < 16; ++k) { acc[k] = col8_sum(acc[k]) + ALPHA * xf[k]; s1_ += acc[k]; s2_ += acc[k] * acc[k]; } \
            s1_ = row8_sum(s1_); s2_ = row8_sum(s2_); \
            if (r8 < 4) { const f32x4 o_ = r8 == 0 ? (f32x4){acc[0], acc[1], acc[2], acc[3]} : r8 == 1 ? (f32x4){acc[4], acc[5], acc[6], acc[7]} : r8 == 2 ? (f32x4){acc[8], acc[9], acc[10], acc[11]} : (f32x4){acc[12], acc[13], acc[14], acc[15]}; \
                *(GAS f32x4*)(F.out + (size_t)(tt) * D + sl * 128 + c8 * 16 + r8 * 4) = o_; } \
            if (lane == 0) { GAS float* st_ = (GAS float*)(F.STATS + ((size_t)(tt) * 8 + sl) * 2); st_[0] = s1_; st_[1] = s2_; } \
        } } while (0)
    S_LOAD_IDX(t); S_PUT_IDX(0); S_ISSUE(bufA, xA, 0, t);
    int tn = t + tstride;
    if (tn < T) S_LOAD_IDX(tn);
#pragma unroll 1
    for (;;) {
        const bool hasB = tn < T;
        if (hasB) { S_PUT_IDX(1); S_ISSUE(bufB, xB, 1, tn); const int t2 = tn + tstride; if (t2 < T) S_LOAD_IDX(t2); }
        S_COMPUTE(bufA, xA, 0, t);
        if (!hasB) break;
        t = tn; tn = t + tstride;
        const bool hasA = tn < T;
        if (hasA) { S_PUT_IDX(0); S_ISSUE(bufA, xA, 0, tn); const int t2 = tn + tstride; if (t2 < T) S_LOAD_IDX(t2); }
        S_COMPUTE(bufB, xB, 1, t);
        if (!hasA) break;
        t = tn; tn = t + tstride;
    }
#undef S_LOAD_IDX
#undef S_PUT_IDX
#undef S_ISSUE
#undef S_CVT16
#undef S_XF
#undef S_COMPUTE
}
__device__ __forceinline__ void peer_coef_phase(Frame& F) {
    const size_t total = (size_t)T * 128, stride = (size_t)F.G * NWAVES * 64;
    for (size_t q = ((size_t)F.vcu * NWAVES + F.wave) * 64 + F.lane; q < total; q += stride) {
        const size_t t = q >> 7; const int j = (int)(q & 127);
        const GAS float* pd = (const GAS float*)(F.PD + t * 1024 + j);
        float d = 0.f;
#pragma unroll
        for (int sl = 0; sl < 8; ++sl) d += pd[sl * 128];
        const int e = F.IDX[q];
        F.GATE[q] = F.GATE[q] * gelu_erf(d * F.USC[e]) * F.VSC[e];
    }
}
__device__ __forceinline__ void ln2_row(Frame& F, int m) {
    GAS f32x4* zr = (GAS f32x4*)(F.out + (size_t)m * D) + F.lane;
    f32x4 v[4];
#pragma unroll
    for (int j = 0; j < 4; ++j) v[j] = zr[64 * j];
    const GAS float* st = (const GAS float*)(F.STATS + (size_t)m * 16);
    float s1 = 0.f, s2 = 0.f;
#pragma unroll
    for (int k = 0; k < 8; ++k) { s1 += st[2 * k]; s2 += st[2 * k + 1]; }
    const float mean = s1 * (1.f / D); const float var = fmaxf(s2 * (1.f / D) - mean * mean, 0.f);
    const float rstd = 1.f / sqrtf(var + LN_EPS);
#pragma unroll
    for (int j = 0; j < 4; ++j) { const f32x4 gg = *((const GAS f32x4*)F.ln2_g + F.lane + 64 * j), bb = *((const GAS f32x4*)F.ln2_b + F.lane + 64 * j);
        zr[64 * j] = (v[j] - mean) * rstd * gg + bb; }
}

struct Args { const float* in[21]; float* out; unsigned char* ws; int ph_lo, ph_hi, li, pad; };
__global__ void __launch_bounds__(NWAVES * 64, 2) fwd_kernel(Args args) {
    extern __shared__ __attribute__((aligned(16))) unsigned char lds[];
    Frame F;
    F.lds = (LAS unsigned char*)lds;
    F.MISC = (volatile LAS unsigned*)(F.lds + MISC_OFF);
    F.tid = threadIdx.x; F.lane = F.tid & 63; F.wave = __builtin_amdgcn_readfirstlane(F.tid >> 6);
    F.G = gridDim.x; { const int bx = blockIdx.x; F.vcu = (F.G % 8 == 0) ? (bx % 8) * (F.G / 8) + bx / 8 : bx; }
    unsigned char* ws = args.ws;
    F.ctl = (gu32*)(ws + WS_CTL);
    F.x = args.in[0]; F.w_in = args.in[1]; F.b_in = args.in[2]; F.cw_dw = args.in[3]; F.cb_dw = args.in[4]; F.cln_g = args.in[5]; F.cln_b = args.in[6];
    F.w_pw2 = args.in[7]; F.b_pw2 = args.in[8]; F.w_o = args.in[9]; F.w_out = args.in[10]; F.b_out = args.in[11]; F.ln1_g = args.in[12]; F.ln1_b = args.in[13];
    F.w_q = args.in[14]; F.keys1 = args.in[15]; F.keys2 = args.in[16]; F.pu = args.in[17]; F.pv = args.in[18]; F.ln2_g = args.in[19]; F.ln2_b = args.in[20];
    F.out = args.out;
    F.WinT = (bf16*)(ws + WS_WIN); F.WvT = (bf16*)(ws + WS_WV); F.Wpw2T = (bf16*)(ws + WS_WPW2); F.WoT = (bf16*)(ws + WS_WO); F.WoutT = (bf16*)(ws + WS_WOUT); F.WeffT = (bf16*)(ws + WS_WEFF);
    F.UT = ws + WS_UT; F.VTAB = ws + WS_VTAB; F.USC = (float*)(ws + WS_USC); F.VSC = (float*)(ws + WS_VSC); F.XB = (bf16*)(ws + WS_XB); F.Cb = (bf16*)(ws + WS_C); F.AO = (bf16*)(ws + WS_AO);
    F.GLU = (bf16*)(ws + WS_GLU); F.Qb = (bf16*)(ws + WS_Q); F.Kb = (bf16*)(ws + WS_K); F.VT = (bf16*)(ws + WS_VT); F.M2 = (bf16*)(ws + WS_M2); F.Gt = (bf16*)(ws + WS_G);
    F.R = (float*)(ws + WS_R); F.ST = (float*)(ws + WS_ST); F.GATE = (float*)(ws + WS_GATE); F.IDX = (int*)(ws + WS_IDX); F.PD = (float*)(ws + WS_PD); F.STATS = (float*)(ws + WS_STATS);
    for (int u = F.tid; u < (LDS_BYTES - LDSCTL_OFF) / 4; u += NWAVES * 64) ((LAS unsigned*)(F.lds + LDSCTL_OFF))[u] = 0u;
    __syncthreads();
    XcdBarrier bar; bar.bar = (unsigned*)(F.ctl + CW_BAR); bar.x = 0; bar.st = nullptr;
    if (MK_N_LAUNCHES == 1) bar = xcd_barrier_post((unsigned*)(F.ctl + CW_BAR), F.MISC + 8);
#define GRID_BAR() do { if (MK_N_LAUNCHES == 1) xcd_barrier(bar); } while (0)
    const int lo = args.ph_lo, hi = args.ph_hi;
#ifdef ONLY_PHASE
#define IN(k) ((k) == ONLY_PHASE && lo <= (k) && (k) < hi)
#elif defined(DBG_STOP)
#define IN(k) ((k) <= DBG_STOP && lo <= (k) && (k) < hi)
#else
#define IN(k) (lo <= (k) && (k) < hi)
#endif
#define BOTH(k) (IN(k) && IN((k) + 1))
    const int gw = F.vcu * NWAVES + F.wave, NGW = F.G * NWAVES;

    if (IN(0)) { for (int rep = 0; rep <= REP(0); ++rep) p0_prologue(F); if (BOTH(0)) GRID_BAR(); }

    if (IN(1)) {
        for (int rep = 0; rep <= REP(1); ++rep) {
        { pg8::Gemm g{F.XB, F.WinT, T, NIN, D, D, D}; pg8::StaticOrder S; S.init(T, NIN, F.G, (int)blockIdx.x);
          pg8::EpiIn E{F.b_in, F.GLU, F.Qb, F.Kb, F.Gt, QSCALE};
          pg8::gemm_phase<pg8::EpiIn, pg8::StaticOrder, true, true>(F.lds + RING_OFF, g, S, E); }
        { pg8::Gemm g{F.WvT, F.XB, SBDIM, T, D, D, D}; pg8::StaticOrder S; S.init(SBDIM, T, F.G, (int)blockIdx.x);
          pg8::EpiVT E{F.b_in + 2048, F.VT, T};
          __syncthreads();
          pg8::gemm_phase<pg8::EpiVT, pg8::StaticOrder, false, true>(F.lds + RING_OFF, g, S, E); }
        }
        if (BOTH(1)) GRID_BAR();
    }

    if (IN(2)) {
        for (int rep = 0; rep <= REP(2); ++rep) {
        for (int ct = F.vcu; ct < T / 64; ct += F.G) conv_unit(F, ct);
        for (int task = gw; task < BATCH * SBH * (SEQ / 32); task += NGW) attn_task(F, task);
        }
        if (BOTH(2)) GRID_BAR();
    }

    if (IN(3)) {
        for (int rep = 0; rep <= REP(3); ++rep) {
        { pg8::Gemm g{F.Cb, F.Wpw2T, T, D, CONVD, CONVD, CONVD}; pg8::StaticOrder S; S.init(T, D, F.G, (int)blockIdx.x);
          pg8::EpiGate E{F.b_pw2, F.Gt, F.M2, 0, 0};
          pg8::gemm_phase<pg8::EpiGate, pg8::StaticOrder, true, true>(F.lds + RING_OFF, g, S, E); }
        { pg8::Gemm g{F.AO, F.WoT, T, D, SBDIM, SBDIM, SBDIM}; pg8::StaticOrder S; S.init(T, D, F.G, (int)blockIdx.x);
          pg8::EpiGate E{nullptr, F.Gt, F.M2, 1024, 1024};
          pg8::gemm_phase<pg8::EpiGate, pg8::StaticOrder, true, true>(F.lds + RING_OFF, g, S, E); }
        }
        if (BOTH(3)) GRID_BAR();
    }

    if (IN(4)) {
        for (int rep = 0; rep <= REP(4); ++rep) {
        pg8::Gemm g{F.M2, F.WoutT, T, D, 2048, 2048, 2048}; pg8::StaticOrder S; S.init(T, D, F.G, (int)blockIdx.x);
        pg8::EpiRes E{F.R, F.x, F.b_out, ALPHA, D};
        pg8::gemm_phase<pg8::EpiRes, pg8::StaticOrder, true, true>(F.lds + RING_OFF, g, S, E);
        }
        if (BOTH(4)) GRID_BAR();
    }

    if (IN(5)) {
        for (int rep = 0; rep <= REP(5); ++rep)
        for (int m = gw; m < T; m += NGW) ln1_row(F, m);
        if (BOTH(5)) GRID_BAR();
    }

    if (IN(6)) {
        for (int rep = 0; rep <= REP(6); ++rep) {
        pg8::Gemm g{F.WeffT, F.XB, 2048, T, D, D, D}; pg8::StaticOrder S; S.init(2048, T, F.G, (int)blockIdx.x);
        pg8::EpiF32 E{F.ST, T};
        pg8::gemm_phase<pg8::EpiF32, pg8::StaticOrder, true, true>(F.lds + RING_OFF, g, S, E);
        }
        if (BOTH(6)) GRID_BAR();
    }

    if (IN(7)) {
        for (int rep = 0; rep <= REP(7); ++rep)
        for (int task = gw; task < (T / 64) * PH; task += NGW) select_task(F, task);
        if (BOTH(7)) GRID_BAR();
    }

    if (IN(8)) {
        for (int rep = 0; rep <= REP(8); ++rep) peer_slice_phase<false>(F);
        if (BOTH(8)) GRID_BAR();
    }
    if (IN(9)) {
        peer_coef_phase(F);
        if (BOTH(9)) GRID_BAR();
    }
    if (IN(10)) {
        for (int rep = 0; rep <= REP(10); ++rep) peer_slice_phase<true>(F);
        if (BOTH(10)) GRID_BAR();
    }
    if (IN(11)) {
        for (int rep = 0; rep <= REP(11); ++rep)
        for (int m = gw; m < T; m += NGW) ln2_row(F, m);
    }
#ifdef DBG_STOP
    if (lo <= 11 && 11 < hi) {
        GRID_BAR();
        { const unsigned long long t0 = __builtin_amdgcn_s_memrealtime(); while (__builtin_amdgcn_s_memrealtime() - t0 < 30000ull) __builtin_amdgcn_s_sleep(32); }
        GRID_BAR();
        const size_t n4 = (size_t)T * D / 4;
        for (size_t i = (size_t)gw * 64 + F.lane; i < n4; i += (size_t)NGW * 64) {
            f32x4 v = (f32x4){0.f, 0.f, 0.f, 0.f};
            if (DBG_STOP == 4) { v = ((const GAS f32x4*)F.R)[i]; v = (f32x4){bflo(f2bf(v.x)), bflo(f2bf(v.y)), bflo(f2bf(v.z)), bflo(f2bf(v.w))}; }
            else if (DBG_STOP == 3) { const v2u w = ((const GAS v2u*)F.M2)[i]; const v2u w2 = ((const GAS v2u*)F.M2)[i + n4]; v = (f32x4){bflo(w.x) + bflo(w2.x), bfhi(w.x) + bfhi(w2.x), bflo(w.y) + bflo(w2.y), bfhi(w.y) + bfhi(w2.y)}; }
            else if (DBG_STOP == 2) { const size_t r = i / 256, c4 = i % 256; const bf16* src = (c4 < 128) ? F.Cb + r * 512 + c4 * 4 : F.AO + r * 512 + (c4 - 128) * 4; const v2u w = *(const GAS v2u*)src; v = (f32x4){bflo(w.x), bfhi(w.x), bflo(w.y), bfhi(w.y)}; }
            else if (DBG_STOP == 1) { const v2u w = ((const GAS v2u*)F.Gt)[i]; v = (f32x4){bflo(w.x), bfhi(w.x), bflo(w.y), bfhi(w.y)}; }
            else if (DBG_STOP == 5) { const v2u w = ((const GAS v2u*)F.XB)[i]; v = (f32x4){bflo(w.x), bfhi(w.x), bflo(w.y), bfhi(w.y)}; }
            else if (DBG_STOP == 6) v = ((const GAS f32x4*)F.ST)[i] + ((const GAS f32x4*)F.ST)[i + n4];
            else if (DBG_STOP == 7) { if (i < (size_t)T * 32) { const v4u w = ((const GAS v4u*)F.IDX)[i]; v = (f32x4){(float)w.x, (float)w.y, (float)w.z, (float)w.w}; } else if (i < (size_t)T * 64) v = ((const GAS f32x4*)F.GATE)[i - (size_t)T * 32]; }
            ((GAS f32x4*)F.out)[i] = v; }
    }
#endif
#undef IN
#undef BOTH
}

extern "C" void kernel_launch(void* const* d_in, const int* in_sizes, int n_in, void* d_out, int out_size, void* d_ws, size_t ws_size, hipStream_t stream) {
    static int grid = 0;
    if (grid == 0) {
        if (n_in != 21 || in_sizes[0] != T * D || out_size != T * D || ws_size < WS_END) { fprintf(stderr, "kernel_launch: unexpected shapes (n_in %d, in0 %d, out %d, ws %zu); nothing launched\n", n_in, n_in > 0 ? in_sizes[0] : -1, out_size, ws_size); grid = -1; return; }
        int dev = 0, cus = 0, per_cu = 0;
        if (hipGetDevice(&dev) != hipSuccess || hipDeviceGetAttribute(&cus, hipDeviceAttributeMultiprocessorCount, dev) != hipSuccess) { grid = -1; return; }
        if (hipFuncSetAttribute((const void*)fwd_kernel, hipFuncAttributeMaxDynamicSharedMemorySize, LDS_BYTES) != hipSuccess) { fprintf(stderr, "kernel_launch: hipFuncSetAttribute failed\n"); grid = -1; return; }
        if (hipOccupancyMaxActiveBlocksPerMultiprocessor(&per_cu, (const void*)fwd_kernel, NWAVES * 64, LDS_BYTES) != hipSuccess || per_cu < 1)
            fprintf(stderr, "kernel_launch: note: occupancy query reports %d workgroups per CU\n", per_cu);
        (void)hipGetLastError();
        grid = cus;
    }
    if (grid < 0) return;
    if (hipMemsetAsync((char*)d_ws + WS_CTL, 0, CTL_ZERO_BYTES, stream) != hipSuccess) return;
    Args a{};
    for (int i = 0; i < 21; ++i) a.in[i] = (const float*)d_in[i];
    a.out = (float*)d_out; a.ws = (unsigned char*)d_ws;
    for (int li = 0; li < MK_N_LAUNCHES; ++li) {
        a.ph_lo = (MK_N_LAUNCHES == 1) ? 0 : li; a.ph_hi = (MK_N_LAUNCHES == 1) ? N_PHASES : li + 1; a.li = li;
        hipLaunchKernelGGL(fwd_kernel, dim3(grid), dim3(NWAVES * 64), LDS_BYTES, stream, a);
    }
}
```

```cpp
#include <hip/hip_runtime.h>
#include <hip/hip_bf16.h>
#include <cstdio>
#include <cstdint>
#include <cmath>

#ifndef REPEAT_MASK
#define REPEAT_MASK 0
#endif
#define REP(k) ((REPEAT_MASK >> (k)) & 1)
#ifndef MK_N_LAUNCHES
#define MK_N_LAUNCHES 1
#endif

namespace pg8 {
#define PG8_LAS __attribute__((address_space(3)))
typedef unsigned short bf16_t;
typedef short bf16x8 __attribute__((ext_vector_type(8)));
typedef float f32x4 __attribute__((ext_vector_type(4)));
typedef unsigned u32x4 __attribute__((ext_vector_type(4)));
constexpr int BM = 256, BK = 64, HALF = 128, HTB = HALF * BK * 2, STAGE_BYTES = 8 * HTB, NXCD = 8, WGM = 8;

__host__ __device__ __forceinline__ int lds_byte(int r, int c) { const int st = (r >> 4) * 2 + (c >> 5), rr = r & 15, cc = c & 31, ob = rr * 64 + cc * 2; return st * 1024 + (ob ^ (((ob >> 9) & 1) << 5)); }
__host__ __device__ __forceinline__ void stage_rc(int b, int& R, int& C) { const int st = b / 1024, sb = b % 1024, swz = sb ^ (((sb >> 9) & 1) << 5); R = (st >> 1) * 16 + swz / 64; C = (st & 1) * 32 + (swz % 64) / 2; }
__host__ __device__ __forceinline__ int perm32(int rho) { const int n = rho >> 4, i = rho & 15; return 8 * (i >> 2) + 4 * n + (i & 3); }

struct Unit { int pm, pn; };
struct Gemm { const bf16_t* A; const bf16_t* Bt; int M, N, K, lda, ldb; };

struct StaticOrder {
    int nM, nN, nwg, G, c;
    __host__ __device__ void init(int M, int N, int G_, int c_) { nM = M / BM; nN = N / BM; nwg = nM * nN; G = G_; c = c_; }
    __host__ __device__ bool next(int i, Unit& u) const {
        const long L = (long)i * G + c; if (L >= nwg) return false;
        int wgid = (int)L; { const int q = nwg / NXCD, r = nwg % NXCD, xcd = wgid % NXCD, off = wgid / NXCD; wgid = (xcd < r ? xcd * (q + 1) : r * (q + 1) + (xcd - r) * q) + off; }
        const int nig = WGM * nN, gid = wgid / nig, fm = gid * WGM, gsz = (nM - fm) < WGM ? (nM - fm) : WGM;
        u.pm = fm + ((wgid % nig) % gsz); u.pn = (wgid % nig) / gsz; return true;
    }
    __device__ __forceinline__ void a_ready(const Unit&) const {}
    __device__ __forceinline__ void done(const Unit&) const {}
};

__device__ __forceinline__ unsigned cvt_pk_bf16(float lo, float hi) { typedef float f2_t __attribute__((ext_vector_type(2))); typedef __bf16 b2_t __attribute__((ext_vector_type(2))); f2_t v = {lo, hi}; b2_t b = __builtin_convertvector(v, b2_t); return __builtin_bit_cast(unsigned, b); }
__device__ __forceinline__ float sigmoid_f(float x) { return __builtin_amdgcn_rcpf(1.0f + __builtin_amdgcn_exp2f(-1.4426950408889634f * x)); }

struct EpiF32 {
    static constexpr bool PERM = false, AFTER_DRAIN = false;
    float* C; int ldc;
    __device__ __forceinline__ void operator()(const f32x4 (&acc)[2][2][4][2], const Unit& u, int wr, int wc, int fr, int fq) const {
        const int row0 = u.pm * BM + wr * 64 + fr, col0 = u.pn * BM + wc * 32 + 4 * fq;
#pragma unroll
        for (int ai = 0; ai < 2; ++ai)
#pragma unroll
            for (int m = 0; m < 4; ++m) { float* rowp = C + (size_t)(row0 + ai * HALF + m * 16) * ldc + col0;
#pragma unroll
                for (int bj = 0; bj < 2; ++bj)
#pragma unroll
                    for (int n = 0; n < 2; ++n) *(f32x4*)(rowp + bj * HALF + n * 16) = acc[ai][bj][m][n]; }
    }
};
struct EpiRes {
    static constexpr bool PERM = false, AFTER_DRAIN = false;
    float* C; const float* X; const float* bias; float alpha; int ldc;
    __device__ __forceinline__ void operator()(const f32x4 (&acc)[2][2][4][2], const Unit& u, int wr, int wc, int fr, int fq) const {
        const int row0 = u.pm * BM + wr * 64 + fr, col0 = u.pn * BM + wc * 32 + 4 * fq;
        f32x4 bv[2][2];
#pragma unroll
        for (int bj = 0; bj < 2; ++bj)
#pragma unroll
            for (int n = 0; n < 2; ++n) bv[bj][n] = *(const f32x4*)(bias + col0 + bj * HALF + n * 16);
#pragma unroll
        for (int ai = 0; ai < 2; ++ai)
#pragma unroll
            for (int m = 0; m < 4; ++m) { const size_t off = (size_t)(row0 + ai * HALF + m * 16) * ldc + col0;
#pragma unroll
                for (int bj = 0; bj < 2; ++bj)
#pragma unroll
                    for (int n = 0; n < 2; ++n) { const f32x4 xv = *(const f32x4*)(X + off + bj * HALF + n * 16);
                        *(f32x4*)(C + off + bj * HALF + n * 16) = acc[ai][bj][m][n] + bv[bj][n] + xv * alpha; } }
    }
};
struct EpiIn {
    static constexpr bool PERM = true, AFTER_DRAIN = false;
    const float* b_in; bf16_t* GLU; bf16_t* Q; bf16_t* Kb; bf16_t* G; float qscale;
    __device__ __forceinline__ void operator()(const f32x4 (&acc)[2][2][4][2], const Unit& u, int wr, int wc, int fr, int fq) const {
        const int row0 = u.pm * BM + wr * 64 + fr; const int cw = wc * 32 + 8 * fq;
        if (u.pn < 4) {
            const int oc = u.pn * 128 + cw;
            const f32x4 ba0 = *(const f32x4*)(b_in + oc), ba1 = *(const f32x4*)(b_in + oc + 4), bg0 = *(const f32x4*)(b_in + 512 + oc), bg1 = *(const f32x4*)(b_in + 512 + oc + 4);
#pragma unroll
            for (int ai = 0; ai < 2; ++ai)
#pragma unroll
                for (int m = 0; m < 4; ++m) { const size_t row = (size_t)(row0 + ai * HALF + m * 16);
                    const f32x4 a0 = acc[ai][0][m][0] + ba0, a1 = acc[ai][0][m][1] + ba1, g0 = acc[ai][1][m][0] + bg0, g1 = acc[ai][1][m][1] + bg1;
                    u32x4 w;
                    w.x = cvt_pk_bf16(a0[0] * sigmoid_f(g0[0]), a0[1] * sigmoid_f(g0[1])); w.y = cvt_pk_bf16(a0[2] * sigmoid_f(g0[2]), a0[3] * sigmoid_f(g0[3]));
                    w.z = cvt_pk_bf16(a1[0] * sigmoid_f(g1[0]), a1[1] * sigmoid_f(g1[1])); w.w = cvt_pk_bf16(a1[2] * sigmoid_f(g1[2]), a1[3] * sigmoid_f(g1[3]));
                    *(u32x4*)(GLU + row * 512 + oc) = w; }
        } else if (u.pn < 8) {
            const int which = (u.pn - 4) >> 1; bf16_t* base = which ? Kb : Q; const float sc = which ? 1.0f : qscale;
#pragma unroll
            for (int bj = 0; bj < 2; ++bj) { const int cwithin = ((u.pn - 4) & 1) * 256 + bj * HALF + cw; const int ocol = 1024 + which * 512 + cwithin;
                const f32x4 b0 = *(const f32x4*)(b_in + ocol), b1 = *(const f32x4*)(b_in + ocol + 4);
#pragma unroll
                for (int ai = 0; ai < 2; ++ai)
#pragma unroll
                    for (int m = 0; m < 4; ++m) { const size_t row = (size_t)(row0 + ai * HALF + m * 16);
                        const f32x4 v0 = (acc[ai][bj][m][0] + b0) * sc, v1 = (acc[ai][bj][m][1] + b1) * sc;
                        u32x4 w; w.x = cvt_pk_bf16(v0[0], v0[1]); w.y = cvt_pk_bf16(v0[2], v0[3]); w.z = cvt_pk_bf16(v1[0], v1[1]); w.w = cvt_pk_bf16(v1[2], v1[3]);
                        *(u32x4*)(base + row * 512 + cwithin) = w; } }
        } else {
#pragma unroll
            for (int bj = 0; bj < 2; ++bj) { const int gcol = (u.pn - 8) * 256 + bj * HALF + cw; const int ocol = 2560 + gcol;
                const f32x4 b0 = *(const f32x4*)(b_in + ocol), b1 = *(const f32x4*)(b_in + ocol + 4);
#pragma unroll
                for (int ai = 0; ai < 2; ++ai)
#pragma unroll
                    for (int m = 0; m < 4; ++m) { const size_t row = (size_t)(row0 + ai * HALF + m * 16);
                        const f32x4 v0 = acc[ai][bj][m][0] + b0, v1 = acc[ai][bj][m][1] + b1;
#ifdef DBG_NOSIG
                        u32x4 w; w.x = cvt_pk_bf16(v0[0], v0[1]); w.y = cvt_pk_bf16(v0[2], v0[3]); w.z = cvt_pk_bf16(v1[0], v1[1]); w.w = cvt_pk_bf16(v1[2], v1[3]);
#else
                        u32x4 w; w.x = cvt_pk_bf16(sigmoid_f(v0[0]), sigmoid_f(v0[1])); w.y = cvt_pk_bf16(sigmoid_f(v0[2]), sigmoid_f(v0[3]));
                        w.z = cvt_pk_bf16(sigmoid_f(v1[0]), sigmoid_f(v1[1])); w.w = cvt_pk_bf16(sigmoid_f(v1[2]), sigmoid_f(v1[3]));
#endif
                        *(u32x4*)(G + row * 2048 + gcol) = w; } }
        }
    }
};
struct EpiVT {
    static constexpr bool PERM = true, AFTER_DRAIN = false;
    const float* rbias; bf16_t* O; int ldc;
    __device__ __forceinline__ void operator()(const f32x4 (&acc)[2][2][4][2], const Unit& u, int wr, int wc, int fr, int fq) const {
        const int row0 = u.pm * BM + wr * 64 + fr; const int col0 = u.pn * BM + wc * 32 + 8 * fq;
#pragma unroll
        for (int ai = 0; ai < 2; ++ai)
#pragma unroll
            for (int m = 0; m < 4; ++m) { const int row = row0 + ai * HALF + m * 16; const float rb = rbias[row];
#pragma unroll
                for (int bj = 0; bj < 2; ++bj) { const f32x4 v0 = acc[ai][bj][m][0] + rb, v1 = acc[ai][bj][m][1] + rb;
                    u32x4 w; w.x = cvt_pk_bf16(v0[0], v0[1]); w.y = cvt_pk_bf16(v0[2], v0[3]); w.z = cvt_pk_bf16(v1[0], v1[1]); w.w = cvt_pk_bf16(v1[2], v1[3]);
                    *(u32x4*)(O + (size_t)row * ldc + col0 + bj * HALF) = w; } }
    }
};
template <bool ADD> struct EpiGate {
    static constexpr bool PERM = true, AFTER_DRAIN = false;
    const float* bias; const bf16_t* Gt; bf16_t* O; int gcol0;
    __device__ __forceinline__ void operator()(const f32x4 (&acc)[2][2][4][2], const Unit& u, int wr, int wc, int fr, int fq) const {
        const int row0 = u.pm * BM + wr * 64 + fr; const int col0 = u.pn * BM + wc * 32 + 8 * fq;
#pragma unroll
        for (int bj = 0; bj < 2; ++bj) { const int c = col0 + bj * HALF;
            f32x4 b0 = (f32x4){0.f, 0.f, 0.f, 0.f}, b1 = b0; if (bias) { b0 = *(const f32x4*)(bias + c); b1 = *(const f32x4*)(bias + c + 4); }
#pragma unroll
            for (int ai = 0; ai < 2; ++ai)
#pragma unroll
                for (int m = 0; m < 4; ++m) { const size_t row = (size_t)(row0 + ai * HALF + m * 16);
                    const u32x4 gw = *(const u32x4*)(Gt + row * 2048 + gcol0 + c);
                    f32x4 v0 = acc[ai][bj][m][0] + b0, v1 = acc[ai][bj][m][1] + b1;
                    v0[0] *= __uint_as_float(gw.x << 16); v0[1] *= __uint_as_float(gw.x & 0xffff0000u); v0[2] *= __uint_as_float(gw.y << 16); v0[3] *= __uint_as_float(gw.y & 0xffff0000u);
                    v1[0] *= __uint_as_float(gw.z << 16); v1[1] *= __uint_as_float(gw.z & 0xffff0000u); v1[2] *= __uint_as_float(gw.w << 16); v1[3] *= __uint_as_float(gw.w & 0xffff0000u);
                    if (ADD) { const u32x4 pw = *(const u32x4*)(O + row * 1024 + c);
                        v0[0] += __uint_as_float(pw.x << 16); v0[1] += __uint_as_float(pw.x & 0xffff0000u); v0[2] += __uint_as_float(pw.y << 16); v0[3] += __uint_as_float(pw.y & 0xffff0000u);
                        v1[0] += __uint_as_float(pw.z << 16); v1[1] += __uint_as_float(pw.z & 0xffff0000u); v1[2] += __uint_as_float(pw.w << 16); v1[3] += __uint_as_float(pw.w & 0xffff0000u); }
                    u32x4 w; w.x = cvt_pk_bf16(v0[0], v0[1]); w.y = cvt_pk_bf16(v0[2], v0[3]); w.z = cvt_pk_bf16(v1[0], v1[1]); w.w = cvt_pk_bf16(v1[2], v1[3]);
                    *(u32x4*)(O + row * 1024 + c) = w; } }
    }
};
struct EpiF16 {
    static constexpr bool PERM = true, AFTER_DRAIN = false;
    unsigned short* C; int ldc;
    __device__ __forceinline__ unsigned pkh(float a, float b) const { typedef float f2_t __attribute__((ext_vector_type(2))); typedef _Float16 h2_t __attribute__((ext_vector_type(2))); f2_t v = {a, b}; h2_t h = __builtin_convertvector(v, h2_t); return __builtin_bit_cast(unsigned, h); }
    __device__ __forceinline__ void operator()(const f32x4 (&acc)[2][2][4][2], const Unit& u, int wr, int wc, int fr, int fq) const {
        const int row0 = u.pm * BM + wr * 64 + fr, col0 = u.pn * BM + wc * 32 + 8 * fq;
#pragma unroll
        for (int ai = 0; ai < 2; ++ai)
#pragma unroll
            for (int m = 0; m < 4; ++m) { unsigned short* rowp = C + (size_t)(row0 + ai * HALF + m * 16) * ldc + col0;
#pragma unroll
                for (int bj = 0; bj < 2; ++bj) { const f32x4 v0 = acc[ai][bj][m][0], v1 = acc[ai][bj][m][1];
                    u32x4 w; w.x = pkh(v0[0], v0[1]); w.y = pkh(v0[2], v0[3]); w.z = pkh(v1[0], v1[1]); w.w = pkh(v1[2], v1[3]);
                    *(u32x4*)(rowp + bj * HALF) = w; } }
    }
};

template <class Epi, class Sched, bool ALIGN_EPI = false, bool SP2 = false>
__device__ __forceinline__ void gemm_phase(PG8_LAS unsigned char* lds, const Gemm g, const Sched& S, const Epi& E) {
    const int tid = threadIdx.x, wid = __builtin_amdgcn_readfirstlane(tid >> 6), lane = tid & 63, wr = wid >> 2, wc = wid & 3, fr = lane & 15, fq = lane >> 4;
    const int K = g.K, nt = K / BK;
    unsigned voffA[2], voffB[2];
#pragma unroll
    for (int i = 0; i < 2; ++i) { int R, C; stage_rc(tid * 16 + i * 8192, R, C); const int Rb = Epi::PERM ? ((R & ~31) + perm32(R & 31)) : R;
        voffA[i] = (unsigned)(R * g.lda + C) * 2u; voffB[i] = (unsigned)(Rb * g.ldb + C) * 2u; }
    const size_t kstep = (size_t)(BK * 2);
    const size_t hstepA = (size_t)HALF * g.lda * 2, hstepB = (size_t)HALF * g.ldb * 2;
    const size_t tstepA = 2 * hstepA, tstepB = 2 * hstepB;
    const unsigned ldsw = (unsigned)wid * 1024u;
    const int aoff = lds_byte(wr * 64 + fr, fq * 8), boff = lds_byte(wc * 32 + fr, fq * 8);
#define PG8_SA(b, h) (((b) * 2 + (h)) * HTB)
#define PG8_SB(b, h) ((4 + (b) * 2 + (h)) * HTB)
#define PG8_STAGE(bufoff, gbase, voff) do { _Pragma("unroll") for (int _i = 0; _i < 2; ++_i) \
        __builtin_amdgcn_global_load_lds((const unsigned*)((const char*)(gbase) + (voff)[_i]), (PG8_LAS unsigned*)(lds + (bufoff) + ldsw + _i * 8192), 16, 0, 0); } while (0)
#define PG8_LDA(dst, b, h) do { _Pragma("unroll") for (int m = 0; m < 4; ++m) _Pragma("unroll") for (int k = 0; k < 2; ++k) dst[m][k] = *(const PG8_LAS bf16x8*)(lds + PG8_SA(b, h) + aoff + m * 2048 + k * 1024); } while (0)
#define PG8_LDB(dst, b, h) do { _Pragma("unroll") for (int n = 0; n < 2; ++n) _Pragma("unroll") for (int k = 0; k < 2; ++k) dst[n][k] = *(const PG8_LAS bf16x8*)(lds + PG8_SB(b, h) + boff + n * 2048 + k * 1024); } while (0)
#define PG8_MMA(ai, bj, At, Bt) do { __builtin_amdgcn_s_setprio(1); _Pragma("unroll") for (int m = 0; m < 4; ++m) _Pragma("unroll") for (int n = 0; n < 2; ++n) _Pragma("unroll") for (int k = 0; k < 2; ++k) \
        acc[ai][bj][m][n] = __builtin_amdgcn_mfma_f32_16x16x32_bf16(Bt[n][k], At[m][k], acc[ai][bj][m][n], 0, 0, 0); __builtin_amdgcn_s_setprio(0); } while (0)
#define PG8_WAIT_V(n) asm volatile("s_waitcnt vmcnt(" #n ")" ::: "memory")
#define PG8_WAIT_L(n) asm volatile("s_waitcnt lgkmcnt(" #n ")" ::: "memory")
#define PG8_BAR __builtin_amdgcn_s_barrier()
#define PG8_SCHED __builtin_amdgcn_sched_barrier(0)
    Unit cur, nxt; int ui = 0;
    if (!S.next(0, cur)) return;
    f32x4 acc[2][2][4][2];
#pragma unroll
    for (int a = 0; a < 2; ++a)
#pragma unroll
        for (int b = 0; b < 2; ++b)
#pragma unroll
            for (int m = 0; m < 4; ++m)
#pragma unroll
                for (int n = 0; n < 2; ++n) acc[a][b][m][n] = (f32x4){0.f, 0.f, 0.f, 0.f};
    bf16x8 At[4][2], B0[2][2], B1[2][2];
    const char* cA = (const char*)g.A + (size_t)cur.pm * tstepA; const char* cB = (const char*)g.Bt + (size_t)cur.pn * tstepB;
    S.a_ready(cur);
    if constexpr (SP2) {
        PG8_STAGE(PG8_SB(0, 0), cB, voffB); PG8_STAGE(PG8_SB(0, 1), cB + hstepB, voffB); PG8_STAGE(PG8_SA(0, 0), cA, voffA); PG8_STAGE(PG8_SA(0, 1), cA + hstepA, voffA);
        if (wr == 1) PG8_BAR;
        PG8_WAIT_V(2); PG8_BAR;
        PG8_STAGE(PG8_SB(1, 0), cB + kstep, voffB); PG8_STAGE(PG8_SA(1, 0), cA + kstep, voffA); PG8_STAGE(PG8_SB(1, 1), cB + hstepB + kstep, voffB);
        PG8_WAIT_V(6); PG8_BAR;
    } else {
        PG8_STAGE(PG8_SB(0, 0), cB, voffB); PG8_STAGE(PG8_SA(0, 0), cA, voffA); PG8_STAGE(PG8_SB(0, 1), cB + hstepB, voffB); PG8_STAGE(PG8_SA(0, 1), cA + hstepA, voffA);
        if (wr == 1) PG8_BAR;
        PG8_WAIT_V(4); PG8_BAR;
        PG8_STAGE(PG8_SB(1, 0), cB + kstep, voffB); PG8_STAGE(PG8_SA(1, 0), cA + kstep, voffA); PG8_STAGE(PG8_SB(1, 1), cB + hstepB + kstep, voffB);
        PG8_WAIT_V(6); PG8_BAR;
    }
    for (;;) {
        const bool has_next = S.next(ui + 1, nxt);
        const char* nA = has_next ? (const char*)g.A + (size_t)nxt.pm * tstepA : cA; const char* nB = has_next ? (const char*)g.Bt + (size_t)nxt.pn * tstepB : cB;
        for (int t = 0; t < nt; t += 2) {
            const bool last = (t == nt - 2);
            const char* a1 = cA + (size_t)(t + 1) * kstep;
            const char* a2 = last ? nA : cA + (size_t)(t + 2) * kstep; const char* b2 = last ? nB : cB + (size_t)(t + 2) * kstep;
            const char* a3 = a2 + kstep; const char* b3 = b2 + kstep;
            if (last && has_next) S.a_ready(nxt);
            if constexpr (SP2) {
            PG8_LDB(B0, 0, 0); PG8_LDB(B1, 0, 1); PG8_SCHED; PG8_LDA(At, 0, 0); PG8_STAGE(PG8_SA(1, 1), a1 + hstepA, voffA);
            PG8_WAIT_V(8); PG8_WAIT_L(0); PG8_BAR; PG8_MMA(0, 0, At, B0); PG8_MMA(0, 1, At, B1); PG8_BAR; PG8_SCHED;
            PG8_LDA(At, 0, 1); PG8_STAGE(PG8_SB(0, 0), b2, voffB); PG8_STAGE(PG8_SB(0, 1), b2 + hstepB, voffB); PG8_STAGE(PG8_SA(0, 0), a2, voffA);
            PG8_WAIT_V(8); PG8_WAIT_L(0); PG8_BAR; PG8_MMA(1, 0, At, B0); PG8_MMA(1, 1, At, B1); PG8_BAR; PG8_SCHED;
            PG8_LDB(B0, 1, 0); PG8_LDB(B1, 1, 1); PG8_SCHED; PG8_LDA(At, 1, 0); PG8_STAGE(PG8_SA(0, 1), a2 + hstepA, voffA);
            PG8_WAIT_V(8); PG8_WAIT_L(0); PG8_BAR; PG8_MMA(0, 0, At, B0); PG8_MMA(0, 1, At, B1); PG8_BAR; PG8_SCHED;
            PG8_LDA(At, 1, 1); PG8_STAGE(PG8_SB(1, 0), b3, voffB); PG8_STAGE(PG8_SB(1, 1), b3 + hstepB, voffB); PG8_STAGE(PG8_SA(1, 0), a3, voffA);
            PG8_WAIT_V(8); PG8_WAIT_L(0); PG8_BAR; PG8_MMA(1, 0, At, B0); PG8_MMA(1, 1, At, B1); PG8_BAR; PG8_SCHED;
            } else {
            PG8_LDB(B0, 0, 0); PG8_SCHED; PG8_LDA(At, 0, 0); PG8_STAGE(PG8_SA(1, 1), a1 + hstepA, voffA);
            PG8_WAIT_L(8); PG8_BAR; PG8_WAIT_L(0); PG8_MMA(0, 0, At, B0); PG8_BAR; PG8_SCHED;
            PG8_LDB(B1, 0, 1); PG8_STAGE(PG8_SB(0, 0), b2, voffB);
            PG8_BAR; PG8_WAIT_L(0); PG8_MMA(0, 1, At, B1); PG8_BAR;
            PG8_LDA(At, 0, 1); PG8_STAGE(PG8_SA(0, 0), a2, voffA);
            PG8_BAR; PG8_WAIT_L(0); PG8_MMA(1, 0, At, B0); PG8_BAR; PG8_SCHED;
            PG8_STAGE(PG8_SB(0, 1), b2 + hstepB, voffB);
            PG8_WAIT_V(6); PG8_BAR; PG8_MMA(1, 1, At, B1); PG8_BAR;
            PG8_LDB(B0, 1, 0); PG8_SCHED; PG8_LDA(At, 1, 0); PG8_STAGE(PG8_SA(0, 1), a2 + hstepA, voffA);
            PG8_WAIT_L(8); PG8_BAR; PG8_WAIT_L(0); PG8_MMA(0, 0, At, B0); PG8_BAR; PG8_SCHED;
            PG8_LDB(B1, 1, 1); PG8_STAGE(PG8_SB(1, 0), b3, voffB);
            PG8_BAR; PG8_WAIT_L(0); PG8_MMA(0, 1, At, B1); PG8_BAR;
            PG8_LDA(At, 1, 1); PG8_STAGE(PG8_SA(1, 0), a3, voffA);
            PG8_BAR; PG8_WAIT_L(0); PG8_MMA(1, 0, At, B0); PG8_BAR; PG8_SCHED;
            PG8_STAGE(PG8_SB(1, 1), b3 + hstepB, voffB);
            PG8_WAIT_V(6); PG8_BAR; PG8_MMA(1, 1, At, B1); PG8_BAR;
            }
        }
        if constexpr (ALIGN_EPI) { if (wr == 0) PG8_BAR; }
        if constexpr (!Epi::AFTER_DRAIN) { E(acc, cur, wr, wc, fr, fq); S.done(cur); }
        if (!has_next) break;
#pragma unroll
        for (int a = 0; a < 2; ++a)
#pragma unroll
            for (int b = 0; b < 2; ++b)
#pragma unroll
                for (int m = 0; m < 4; ++m)
#pragma unroll
                    for (int n = 0; n < 2; ++n) acc[a][b][m][n] = (f32x4){0.f, 0.f, 0.f, 0.f};
        cur = nxt; cA = nA; cB = nB; ++ui;
        if constexpr (ALIGN_EPI) { if (wr == 1) PG8_BAR; }
    }
    PG8_WAIT_V(0);
    if constexpr (!ALIGN_EPI) { if (wr == 0) PG8_BAR; }
    PG8_BAR;
#undef PG8_SA
#undef PG8_SB
#undef PG8_STAGE
#undef PG8_LDA
#undef PG8_LDB
#undef PG8_MMA
#undef PG8_WAIT_V
#undef PG8_WAIT_L
#undef PG8_BAR
#undef PG8_SCHED
}
}

constexpr int NWAVES = 8;
constexpr int BATCH = 8, SEQ = 4096, D = 1024, T = BATCH * SEQ;
constexpr int CONVD = 512, CONVW = 31, SBH = 8, SBD = 64, SBDIM = 512;
constexpr int PH = 8, NKEYS = 128, TOPK = 16, NEXP = NKEYS * NKEYS;
constexpr int NIN = 4096;
constexpr float LN_EPS = 1e-5f;
constexpr float ALPHA = 1.189207115002721f;
constexpr float QSCALE = 0.125f * 1.4426950408889634f;
constexpr int N_PHASES = 12;

constexpr size_t MiB = 1u << 20;
constexpr size_t WS_CTL = 0, CTL_ZERO_BYTES = 1 * MiB;
constexpr size_t WS_WIN = 2 * MiB;
constexpr size_t WS_WV = 10 * MiB;
constexpr size_t WS_WPW2 = 11 * MiB;
constexpr size_t WS_WO = 12 * MiB;
constexpr size_t WS_WOUT = 13 * MiB;
constexpr size_t WS_WEFF = 17 * MiB;
constexpr size_t WS_IDX = 21 * MiB;
constexpr size_t WS_GATE = 37 * MiB;
constexpr size_t WS_UT = 53 * MiB;
constexpr size_t WS_VTAB = 85 * MiB;
constexpr size_t WS_USC = 70 * MiB;
constexpr size_t WS_VSC = 102 * MiB;
constexpr size_t WS_XB = 117 * MiB;
constexpr size_t WS_C = 181 * MiB;
constexpr size_t WS_AO = 213 * MiB;
constexpr size_t WS_GLU = 373 * MiB;
constexpr size_t WS_Q = 405 * MiB;
constexpr size_t WS_K = 437 * MiB;
constexpr size_t WS_VT = 469 * MiB;
constexpr size_t WS_M2 = 373 * MiB;
constexpr size_t WS_G = 245 * MiB;
constexpr size_t WS_R = 245 * MiB;
constexpr size_t WS_ST = 245 * MiB;
constexpr size_t WS_PD = 245 * MiB;
constexpr size_t WS_STATS = 373 * MiB;
constexpr size_t WS_END = 501 * MiB;
constexpr int CW_BAR = 4096;

constexpr int RING_OFF = 0, RING_BYTES = 131072;
constexpr int LDSCTL_OFF = RING_BYTES, MISC_OFF = LDSCTL_OFF + 320;
constexpr int LDS_BYTES = 147456;

#define GAS __attribute__((address_space(1)))
#define LAS __attribute__((address_space(3)))
typedef unsigned short bf16;
typedef unsigned v4u __attribute__((ext_vector_type(4)));
typedef unsigned v2u __attribute__((ext_vector_type(2)));
typedef float f32x4 __attribute__((ext_vector_type(4)));
typedef float f32x16 __attribute__((ext_vector_type(16)));
typedef float f32x2 __attribute__((ext_vector_type(2)));
typedef short bf16x8 __attribute__((ext_vector_type(8)));
typedef GAS unsigned gu32;
#define RLX_AGENT __ATOMIC_RELAXED, __HIP_MEMORY_SCOPE_AGENT
#define LDS_WAIT() asm volatile("s_waitcnt lgkmcnt(0)" ::: "memory")
#define VM_WAIT() asm volatile("s_waitcnt vmcnt(0)" ::: "memory")
__device__ __forceinline__ unsigned f2bf(float f) { unsigned u = __builtin_bit_cast(unsigned, f); return (u + 0x7fffu + ((u >> 16) & 1u)) >> 16; }
__device__ __forceinline__ unsigned pk2(float lo, float hi) { return f2bf(lo) | (f2bf(hi) << 16); }
__device__ __forceinline__ float bflo(unsigned w) { return __uint_as_float(w << 16); }
__device__ __forceinline__ float bfhi(unsigned w) { return __uint_as_float(w & 0xffff0000u); }

#define XB_TMO      128
#define XB_XCNT(j)  (256  + 64 * (j))
#define XB_XSUB(j)  (1280 + 64 * (j))
#define XB_XGEN(j)  (2304 + 64 * (j))
#define XB_TOP      3328
#define XB_TOPGEN   3392
#define XCD_BAR_WORDS 3456
#define XB_SPIN_CAP (1u << 18)
__device__ __forceinline__ unsigned xb_ld(unsigned* p)              { return __hip_atomic_load(p, __ATOMIC_RELAXED, __HIP_MEMORY_SCOPE_AGENT); }
__device__ __forceinline__ unsigned xb_add(unsigned* p, unsigned v) { return __hip_atomic_fetch_add(p, v, __ATOMIC_RELAXED, __HIP_MEMORY_SCOPE_AGENT); }
__device__ __forceinline__ unsigned xb_xcc_id() { return (unsigned)__builtin_amdgcn_s_getreg((3 << 11) | 20) & 0xFu; }
#define XB_SPIN(cond, bar) do { unsigned _sp = 0; while (cond) { __builtin_amdgcn_s_sleep(1); \
    if ((++_sp & 255u) == 0u) { if (xb_ld(&(bar)[XB_TMO])) break; if (_sp > XB_SPIN_CAP) { atomicAdd(&(bar)[XB_TMO], 1u); break; } } } } while (0)
struct XcdBarrier { unsigned* bar; unsigned x; volatile LAS unsigned* st; };
__device__ __forceinline__ XcdBarrier xcd_barrier_post(unsigned* bar, volatile LAS unsigned* st) {
    XcdBarrier b; b.bar = bar; b.x = xb_xcc_id(); b.st = st;
    if (threadIdx.x == 0) (void)xb_add(&bar[XB_XCNT(b.x)], 1u);
    return b;
}
__device__ __forceinline__ void xcd_barrier_complete(unsigned* bar, unsigned x, unsigned& nloc, unsigned& nx) {
    const unsigned G = gridDim.x * gridDim.y * gridDim.z;
    unsigned sum, cnt, mine, sp = 0u;
    for (;;) {
        sum = 0u; cnt = 0u; mine = 0u;
#pragma unroll
        for (unsigned j = 0; j < 16; ++j) { const unsigned c = xb_ld(&bar[XB_XCNT(j)]); sum += c; cnt += (c > 0u) ? 1u : 0u; mine = (j == x) ? c : mine; }
        if (sum == G) break;
        __builtin_amdgcn_s_sleep(1);
        if ((++sp & 255u) == 0u) { if (xb_ld(&bar[XB_TMO])) break; if (sp > XB_SPIN_CAP) { atomicAdd(&bar[XB_TMO], 1u); break; } }
    }
    nloc = mine > 0u ? mine : 1u; nx = cnt > 0u ? cnt : 1u;
}
__device__ __forceinline__ void xcd_barrier(const XcdBarrier& b) {
    asm volatile("s_waitcnt vmcnt(0)" ::: "memory");
    __syncthreads();
    if (threadIdx.x == 0) {
        unsigned* bar = b.bar;
        __builtin_amdgcn_s_waitcnt(0);
        unsigned nloc = b.st[0], nx = b.st[1];
        if (nloc == 0u) { xcd_barrier_complete(bar, b.x, nloc, nx); b.st[0] = nloc; b.st[1] = nx; }
        const unsigned old = xb_add(&bar[XB_XSUB(b.x)], 1u);
        const unsigned gen = old / nloc;
        if (old + 1u == (gen + 1u) * nloc) {
            __builtin_amdgcn_fence(__ATOMIC_RELEASE, "agent");
            asm volatile("s_waitcnt vmcnt(0)" ::: "memory");
            const unsigned og = xb_add(&bar[XB_TOP], 1u);
            const unsigned tg = og / nx;
            if (og + 1u == (tg + 1u) * nx) xb_add(&bar[XB_TOPGEN], 1u);
            else XB_SPIN(xb_ld(&bar[XB_TOPGEN]) == tg, bar);
            __builtin_amdgcn_fence(__ATOMIC_ACQUIRE, "agent");
            xb_add(&bar[XB_XGEN(b.x)], 1u);
            asm volatile("s_waitcnt vmcnt(0)" ::: "memory");
        } else {
            XB_SPIN(xb_ld(&bar[XB_XGEN(b.x)]) == gen, bar);
            __builtin_amdgcn_fence(__ATOMIC_ACQUIRE, "agent");
            asm volatile("s_waitcnt vmcnt(0)" ::: "memory");
        }
    }
    __syncthreads();
}

struct Frame {
    LAS unsigned char* lds;
    volatile LAS unsigned* MISC;
    gu32* ctl;
    int tid, lane, wave;
    int vcu, G;
    const float *x, *w_in, *b_in, *cw_dw, *cb_dw, *cln_g, *cln_b, *w_pw2, *b_pw2, *w_o, *w_out, *b_out, *ln1_g, *ln1_b, *w_q, *keys1, *keys2, *pu, *pv, *ln2_g, *ln2_b;
    float* out;
    unsigned char *UT, *VTAB; float *USC, *VSC;
    bf16 *WinT, *WvT, *Wpw2T, *WoT, *WoutT, *WeffT, *XB, *Cb, *AO, *GLU, *Qb, *Kb, *VT, *M2, *Gt;
    float *R, *ST, *GATE, *PD, *STATS; int* IDX;
};

__device__ __forceinline__ float wave_sum(float v) {
#pragma unroll
    for (int o = 1; o < 64; o <<= 1) v += __shfl_xor(v, o);
    return v;
}

__device__ __forceinline__ void p0_transpose_item(const float* W, int ldw, int src_col0, int k0, bf16* WT, int ldt, int dst_row0, int dst_k0, LAS float* scr, int lane) {
#pragma unroll 8
    for (int i = 0; i < 32; ++i) { const int kk = 2 * i + (lane >> 5); scr[kk * 33 + (lane & 31)] = W[(size_t)(k0 + kk) * ldw + src_col0 + (lane & 31)]; }
    LDS_WAIT(); asm volatile("" ::: "memory");
    const int c = lane & 7;
#pragma unroll
    for (int j = 0; j < 4; ++j) { const int n = (lane >> 3) + 8 * j; const LAS float* s = scr + (8 * c) * 33 + n;
        v4u o; o.x = pk2(s[0 * 33], s[1 * 33]); o.y = pk2(s[2 * 33], s[3 * 33]); o.z = pk2(s[4 * 33], s[5 * 33]); o.w = pk2(s[6 * 33], s[7 * 33]);
        *(GAS v4u*)(WT + (size_t)(dst_row0 + n) * ldt + dst_k0 + 8 * c) = o; }
    LDS_WAIT(); asm volatile("" ::: "memory");
}
__device__ __forceinline__ void p0_convert(const float* src, bf16* dst, size_t n8, int gw, int NGW, int lane) {
    for (size_t i = (size_t)gw * 64 + lane; i < n8; i += (size_t)NGW * 64) {
        const f32x4 a = *(const GAS f32x4*)(src + i * 8), b = *(const GAS f32x4*)(src + i * 8 + 4);
        v4u o; o.x = pk2(a.x, a.y); o.y = pk2(a.z, a.w); o.z = pk2(b.x, b.y); o.w = pk2(b.z, b.w);
        *(GAS v4u*)(dst + i * 8) = o; }
}
__device__ __forceinline__ float wave_max(float v) {
#pragma unroll
    for (int o = 1; o < 64; o <<= 1) v = fmaxf(v, __shfl_xor(v, o));
    return v;
}
__device__ __forceinline__ void p0_row_fp8(const float* src, unsigned char* dst, float* inv_scale, int lane) {
    f32x4 v[4]; float m = 0.f;
#pragma unroll
    for (int j = 0; j < 4; ++j) { v[j] = *(const GAS f32x4*)(src + 16 * lane + 4 * j); m = fmaxf(m, fmaxf(fmaxf(fabsf(v[j].x), fabsf(v[j].y)), fmaxf(fabsf(v[j].z), fabsf(v[j].w)))); }
    m = wave_max(m);
    const float sc = m > 0.f ? 256.0f / m : 1.0f;
    v4u o; unsigned w;
    w = 0u; w = __builtin_amdgcn_cvt_pk_fp8_f32(v[0].x * sc, v[0].y * sc, w, false); w = __builtin_amdgcn_cvt_pk_fp8_f32(v[0].z * sc, v[0].w * sc, w, true); o.x = w;
    w = 0u; w = __builtin_amdgcn_cvt_pk_fp8_f32(v[1].x * sc, v[1].y * sc, w, false); w = __builtin_amdgcn_cvt_pk_fp8_f32(v[1].z * sc, v[1].w * sc, w, true); o.y = w;
    w = 0u; w = __builtin_amdgcn_cvt_pk_fp8_f32(v[2].x * sc, v[2].y * sc, w, false); w = __builtin_amdgcn_cvt_pk_fp8_f32(v[2].z * sc, v[2].w * sc, w, true); o.z = w;
    w = 0u; w = __builtin_amdgcn_cvt_pk_fp8_f32(v[3].x * sc, v[3].y * sc, w, false); w = __builtin_amdgcn_cvt_pk_fp8_f32(v[3].z * sc, v[3].w * sc, w, true); o.w = w;
    *(GAS v4u*)(dst + ((size_t)(lane >> 3) << 21) + 16 * (lane & 7)) = o;
    if (lane == 0) *inv_scale = m > 0.f ? m * (1.0f / 256.0f) : 1.0f;
}
__device__ __forceinline__ void p0_weff_tile(Frame& F, int tile) {
    const int lane = F.lane, r32 = lane & 31, hi = lane >> 5;
    const int it = tile & 31, kt = (tile >> 5) & 3, g = tile >> 7;
    const int h = g >> 1, half = g & 1;
    const float* kp = (half ? F.keys2 : F.keys1) + ((size_t)h * NKEYS + kt * 32 + r32) * 128 + 64 * hi;
    const float* wp = F.w_q + (size_t)(it * 32 + r32) * 2048 + g * 128 + 64 * hi;
    f32x4 a[16], b[16];
#pragma unroll
    for (int j = 0; j < 16; ++j) { a[j] = *(const GAS f32x4*)(kp + 4 * j); b[j] = *(const GAS f32x4*)(wp + 4 * j); }
    f32x16 c = {};
#pragma unroll
    for (int j = 0; j < 16; ++j)
#pragma unroll
        for (int e = 0; e < 4; ++e) c = __builtin_amdgcn_mfma_f32_32x32x2f32(a[j][e], b[j][e], c, 0, 0, 0);
#pragma unroll
    for (int r = 0; r < 16; ++r) { const int row = (r & 3) + 8 * (r >> 2) + 4 * hi;
        F.WeffT[(size_t)(g * 128 + kt * 32 + row) * 1024 + it * 32 + r32] = (bf16)f2bf(c[r]); }
}
__device__ __forceinline__ void p0_prologue(Frame& F) {
    LAS float* scr = (LAS float*)(F.lds + RING_OFF + F.wave * 16384);
    const int gw = F.vcu * NWAVES + F.wave, NGW = F.G * NWAVES;
    constexpr int I_IN = 16 * 128, I_V = 16 * 16, I_P = 8 * 32, I_O = 8 * 32, I_W = 16 * 32;
    constexpr int NITEMS = I_IN + I_V + I_P + I_O + I_W;
    for (int itx = gw; itx < NITEMS; itx += NGW) {
        int r = itx;
        if (r < I_IN) { const int kb = r / 128, nb = r % 128, j0 = nb * 32;
            int oc; if (j0 < 1024) { const int pn = j0 >> 8, w = j0 & 255; oc = (w < 128) ? pn * 128 + w : 512 + pn * 128 + (w - 128); } else if (j0 < 2048) oc = j0; else oc = j0 + 512;
            p0_transpose_item(F.w_in, 4608, oc, kb * 64, F.WinT, 1024, j0, kb * 64, scr, F.lane); continue; } r -= I_IN;
        if (r < I_V) { const int kb = r / 16, nb = r % 16; p0_transpose_item(F.w_in, 4608, 2048 + nb * 32, kb * 64, F.WvT, 1024, nb * 32, kb * 64, scr, F.lane); continue; } r -= I_V;
        if (r < I_P) { const int kb = r / 32, nb = r % 32; p0_transpose_item(F.w_pw2, 1024, nb * 32, kb * 64, F.Wpw2T, 512, nb * 32, kb * 64, scr, F.lane); continue; } r -= I_P;
        if (r < I_O) { const int kb = r / 32, nb = r % 32; p0_transpose_item(F.w_o, 1024, nb * 32, kb * 64, F.WoT, 512, nb * 32, kb * 64, scr, F.lane); continue; } r -= I_O;
        { const int kb = r / 32, nb = r % 32; p0_transpose_item(F.w_out, 1024, nb * 32, kb * 64, F.WoutT, 1024, nb * 32, kb * 64, scr, F.lane); }
    }
    for (int tile = gw; tile < 2048; tile += NGW) p0_weff_tile(F, tile);
    p0_convert(F.x, F.XB, (size_t)T * D / 8, gw, NGW, F.lane);
    for (int r = gw; r < 2 * NEXP; r += NGW) { if (r < NEXP) p0_row_fp8(F.pu + (size_t)r * D, F.UT + (size_t)r * 128, F.USC + r, F.lane); else p0_row_fp8(F.pv + (size_t)(r - NEXP) * D, F.VTAB + (size_t)(r - NEXP) * 128, F.VSC + (r - NEXP), F.lane); }
}

__device__ __forceinline__ void conv_unit(Frame& F, int ct) {
    const int tid = F.tid, lane = F.lane, w = F.wave;
    const int tb = ct * 64, p0 = tb & (SEQ - 1);
    LAS unsigned char* L = F.lds + RING_OFF;
    for (int c = tid; c < 94 * 64; c += NWAVES * 64) { const int r = c >> 6, ch = c & 63; v4u v = (v4u){0u, 0u, 0u, 0u};
        if (p0 - 30 + r >= 0) v = *(const GAS v4u*)(F.GLU + (size_t)(tb - 30 + r) * CONVD + ch * 8);
        *(LAS v4u*)(L + r * 1024 + ch * 16) = v; }
    __syncthreads();
    float s1[8], s2[8];
#pragma unroll
    for (int i = 0; i < 8; ++i) { s1[i] = 0.f; s2[i] = 0.f; }
#define CONV_BODY() \
        const int p = lane + 64 * q, c0 = 2 * p; \
        const f32x2 bb = *(const GAS f32x2*)(F.cb_dw + c0); \
        float a0[8], a1[8]; \
        _Pragma("unroll") for (int i = 0; i < 8; ++i) { a0[i] = bb.x; a1[i] = bb.y; } \
        float w0[CONVW], w1[CONVW]; \
        _Pragma("unroll") for (int rr = 0; rr < 38; ++rr) { \
            if (rr < CONVW) { const f32x2 ww = *(const GAS f32x2*)(F.cw_dw + rr * CONVD + c0); w0[rr] = ww.x; w1[rr] = ww.y; } \
            const unsigned g2 = *(const LAS unsigned*)(L + (8 * w + rr) * 1024 + p * 4); \
            const float lo = bflo(g2), hi = bfhi(g2); \
            _Pragma("unroll") for (int i = 0; i < 8; ++i) { const int j = rr - i; if (j >= 0 && j < CONVW) { a0[i] += w0[j] * lo; a1[i] += w1[j] * hi; } } \
        }
#pragma unroll 1
    for (int q = 0; q < 4; ++q) {
        CONV_BODY()
#pragma unroll
        for (int i = 0; i < 8; ++i) { s1[i] += a0[i] + a1[i]; s2[i] += a0[i] * a0[i] + a1[i] * a1[i]; }
    }
    float mean[8], rstd[8];
#pragma unroll
    for (int i = 0; i < 8; ++i) { mean[i] = wave_sum(s1[i]) * (1.0f / CONVD); const float var = wave_sum(s2[i]) * (1.0f / CONVD) - mean[i] * mean[i];
        rstd[i] = 1.0f / sqrtf(fmaxf(var, 0.f) + LN_EPS); }
#pragma unroll 1
    for (int q = 0; q < 4; ++q) {
        CONV_BODY()
        const f32x2 gg = *(const GAS f32x2*)(F.cln_g + c0), lb = *(const GAS f32x2*)(F.cln_b + c0);
#pragma unroll
        for (int i = 0; i < 8; ++i) { float v0 = (a0[i] - mean[i]) * rstd[i] * gg.x + lb.x, v1 = (a1[i] - mean[i]) * rstd[i] * gg.y + lb.y;
            v0 = v0 * pg8::sigmoid_f(v0); v1 = v1 * pg8::sigmoid_f(v1);
            *(GAS unsigned*)(F.Cb + (size_t)(tb + 8 * w + i) * CONVD + c0) = pk2(v0, v1); }
    }
#undef CONV_BODY
    __syncthreads();
}

__device__ __forceinline__ unsigned cvtpk_s(float lo, float hi) { typedef float f2 __attribute__((ext_vector_type(2))); typedef __bf16 b2 __attribute__((ext_vector_type(2))); f2 v = {lo, hi}; b2 b = __builtin_convertvector(v, b2); return __builtin_bit_cast(unsigned, b); }
__device__ __forceinline__ void attn_task(Frame& F, int task) {
    const int lane = F.lane, r32 = lane & 31, hi = lane >> 5;
    const int qblk = task & 127, h = (task >> 7) & 7, b = task >> 10;
    const int q0 = qblk * 32; const size_t rowbase = (size_t)b * SEQ;
    bf16x8 qf[4];
#pragma unroll
    for (int d0 = 0; d0 < 4; ++d0) qf[d0] = *(const GAS bf16x8*)(F.Qb + (rowbase + q0 + r32) * SBDIM + h * SBD + d0 * 16 + hi * 8);
    f32x16 o0 = {}, o1 = {};
    float Rc = 1.0f;
    const int kperm = 32 * ((r32 >> 2) & 1) + 4 * (r32 >> 3) + (r32 & 3);
    const int jt0 = q0 >> 6;
    const int qpos = q0 + r32;
    for (int jt = jt0; jt >= 0; --jt) {
        const int t0 = jt * 64;
        bf16x8 kf[2][4];
#pragma unroll
        for (int p = 0; p < 2; ++p)
#pragma unroll
            for (int d0 = 0; d0 < 4; ++d0) kf[p][d0] = *(const GAS bf16x8*)(F.Kb + (rowbase + t0 + kperm + 16 * p) * SBDIM + h * SBD + d0 * 16 + hi * 8);
        bf16x8 vf[2][2][2];
#pragma unroll
        for (int dt = 0; dt < 2; ++dt)
#pragma unroll
            for (int p = 0; p < 2; ++p)
#pragma unroll
                for (int s = 0; s < 2; ++s) vf[dt][p][s] = *(const GAS bf16x8*)(F.VT + (size_t)(h * SBD + dt * 32 + r32) * T + rowbase + t0 + 32 * hi + 16 * p + 8 * s);
        f32x16 sp[2];
#pragma unroll
        for (int p = 0; p < 2; ++p) { sp[p] = (f32x16){};
#pragma unroll
            for (int d0 = 0; d0 < 4; ++d0) sp[p] = __builtin_amdgcn_mfma_f32_32x32x16_bf16(kf[p][d0], qf[d0], sp[p], 0, 0, 0); }
        float rr[32], be[32];
#pragma unroll
        for (int p = 0; p < 2; ++p)
#pragma unroll
            for (int r = 0; r < 16; ++r) { const float e = __builtin_amdgcn_exp2f(sp[p][r]); const float om = __builtin_amdgcn_rcpf(1.0f + e); rr[16 * p + r] = om; be[16 * p + r] = 1.0f - om; }
        if (jt == jt0) {
#pragma unroll
            for (int i = 0; i < 32; ++i) { const bool valid = (t0 + 32 * hi + i) < qpos; rr[i] = valid ? rr[i] : 1.0f; be[i] = valid ? be[i] : 0.0f; }
        }
        float tt[16];
#pragma unroll
        for (int i = 0; i < 16; ++i) tt[i] = rr[2 * i] * rr[2 * i + 1];
#pragma unroll
        for (int i = 0; i < 8; ++i) tt[i] = tt[2 * i] * tt[2 * i + 1];
#pragma unroll
        for (int i = 0; i < 4; ++i) tt[i] = tt[2 * i] * tt[2 * i + 1];
        const float tot = (tt[0] * tt[1]) * (tt[2] * tt[3]);
        const float oth = __shfl_xor(tot, 32);
        float run = hi ? Rc : Rc * oth;
        Rc = Rc * tot * oth;
        float pa[32];
#pragma unroll
        for (int i = 31; i >= 0; --i) { pa[i] = be[i] * run; run *= rr[i]; }
#pragma unroll
        for (int p = 0; p < 2; ++p)
#pragma unroll
            for (int s = 0; s < 2; ++s) { v4u pw; const int bs = 16 * p + 8 * s;
                pw.x = cvtpk_s(pa[bs], pa[bs + 1]); pw.y = cvtpk_s(pa[bs + 2], pa[bs + 3]); pw.z = cvtpk_s(pa[bs + 4], pa[bs + 5]); pw.w = cvtpk_s(pa[bs + 6], pa[bs + 7]);
                const bf16x8 pf = __builtin_bit_cast(bf16x8, pw);
                o0 = __builtin_amdgcn_mfma_f32_32x32x16_bf16(pf, vf[0][p][s], o0, 0, 0, 0);
                o1 = __builtin_amdgcn_mfma_f32_32x32x16_bf16(pf, vf[1][p][s], o1, 0, 0, 0); }
        if (__all(Rc < 1e-12f)) break;
    }
#pragma unroll
    for (int r = 0; r < 16; ++r) { const int q = (r & 3) + 8 * (r >> 2) + 4 * hi; bf16* op = F.AO + (rowbase + q0 + q) * SBDIM + h * SBD + r32;
        op[0] = (bf16)f2bf(o0[r]); op[32] = (bf16)f2bf(o1[r]); }
}

__device__ __forceinline__ void ln1_row(Frame& F, int m) {
    const GAS f32x4* xr = (const GAS f32x4*)(F.R + (size_t)m * D) + F.lane;
    f32x4 v[4]; float s = 0.f;
#pragma unroll
    for (int j = 0; j < 4; ++j) { v[j] = xr[64 * j]; s += (v[j].x + v[j].y) + (v[j].z + v[j].w); }
    const float mean = wave_sum(s) * (1.f / D); float s2 = 0.f;
#pragma unroll
    for (int j = 0; j < 4; ++j) { v[j] = v[j] - mean; s2 += (v[j].x * v[j].x + v[j].y * v[j].y) + (v[j].z * v[j].z + v[j].w * v[j].w); }
    const float rstd = 1.f / sqrtf(wave_sum(s2) * (1.f / D) + LN_EPS);
    GAS v2u* o8 = (GAS v2u*)(F.XB + (size_t)m * D) + F.lane;
#pragma unroll
    for (int j = 0; j < 4; ++j) { const f32x4 gg = *((const GAS f32x4*)F.ln1_g + F.lane + 64 * j), bb = *((const GAS f32x4*)F.ln1_b + F.lane + 64 * j);
        const f32x4 y = v[j] * rstd * gg + bb; v2u o; o.x = pk2(y.x, y.y); o.y = pk2(y.z, y.w); o8[64 * j] = o; }
}

#define CE_DESC(a, b) do { const unsigned _x = (a), _y = (b); (a) = _x > _y ? _x : _y; (b) = _x > _y ? _y : _x; } while (0)
__device__ __forceinline__ unsigned f2key(float f) { const unsigned u = __float_as_uint(f); return (u & 0x80000000u) ? ~u : (u | 0x80000000u); }
__device__ __forceinline__ float key2f(unsigned k) { const unsigned u = (k & 0x80000000u) ? (k & 0x7fffffffu) : ~k; return __uint_as_float(u); }
__device__ __forceinline__ void sort16_desc(unsigned (&a)[16]) {
#pragma unroll
    for (int k = 2; k <= 16; k <<= 1)
#pragma unroll
        for (int j = k >> 1; j > 0; j >>= 1)
#pragma unroll
            for (int i = 0; i < 16; ++i) { const int l = i ^ j; if (l > i) { if ((i & k) == 0) CE_DESC(a[i], a[l]); else CE_DESC(a[l], a[i]); } }
}
__device__ __forceinline__ void merge16_desc(unsigned (&t)[16], const unsigned (&c)[16]) {
#pragma unroll
    for (int i = 0; i < 16; ++i) t[i] = t[i] > c[15 - i] ? t[i] : c[15 - i];
#pragma unroll
    for (int j = 8; j > 0; j >>= 1)
#pragma unroll
        for (int i = 0; i < 16; ++i) { const int l = i ^ j; if (l > i) CE_DESC(t[i], t[l]); }
}
__device__ __forceinline__ void top16_of_128(const _Float16* col, unsigned (&top)[16]) {
#pragma unroll 1
    for (int c = 0; c < 8; ++c) {
        unsigned a[16];
#pragma unroll
        for (int i = 0; i < 16; ++i) { const float v = (float)*(const GAS _Float16*)(col + (size_t)(c * 16 + i) * T); a[i] = (f2key(v) & ~127u) | (unsigned)(127 - (c * 16 + i)); }
        sort16_desc(a);
        if (c == 0) {
#pragma unroll
            for (int i = 0; i < 16; ++i) top[i] = a[i];
        } else merge16_desc(top, a);
    }
}
__device__ __forceinline__ void select_task(Frame& F, int task) {
    const int lane = F.lane, w = F.wave;
    const int h = task & 7, tblk = task >> 3; const int t = tblk * 64 + lane;
    unsigned v1[16], v2[16];
    top16_of_128((const _Float16*)F.ST + (size_t)(h * 256) * T + t, v1);
    top16_of_128((const _Float16*)F.ST + (size_t)(h * 256 + 128) * T + t, v2);
    LAS unsigned* L = (LAS unsigned*)(F.lds + RING_OFF) + w * 2048;
#pragma unroll
    for (int i = 0; i < 16; ++i) { L[i * 64 + lane] = v1[i]; L[(16 + i) * 64 + lane] = v2[i]; }
    float f1[16], f2[16];
#pragma unroll
    for (int i = 0; i < 16; ++i) { f1[i] = key2f(v1[i] & ~127u); f2[i] = key2f(v2[i] & ~127u); }
    unsigned top[16], cg[16];
#define CAND(i, j) ((f2key(f1[i] + f2[j]) & ~255u) | (unsigned)((i) * 16 + (j)))
#pragma unroll
    for (int j = 0; j < 16; ++j) top[j] = CAND(0, j);
    sort16_desc(top);
#pragma unroll
    for (int j = 0; j < 8; ++j) { cg[j] = CAND(1, j); cg[8 + j] = CAND(8 + j, 0); }
    sort16_desc(cg); merge16_desc(top, cg);
    cg[0] = CAND(2, 0); cg[1] = CAND(2, 1); cg[2] = CAND(2, 2); cg[3] = CAND(2, 3); cg[4] = CAND(2, 4);
    cg[5] = CAND(3, 0); cg[6] = CAND(3, 1); cg[7] = CAND(3, 2); cg[8] = CAND(3, 3);
    cg[9] = CAND(4, 0); cg[10] = CAND(4, 1); cg[11] = CAND(4, 2);
    cg[12] = CAND(5, 0); cg[13] = CAND(5, 1); cg[14] = CAND(6, 0); cg[15] = CAND(6, 1);
    sort16_desc(cg); merge16_desc(top, cg);
    cg[0] = CAND(7, 0); cg[1] = CAND(7, 1);
#pragma unroll
    for (int j = 2; j < 16; ++j) cg[j] = 0u;
    sort16_desc(cg); merge16_desc(top, cg);
#undef CAND
    LDS_WAIT(); asm volatile("" ::: "memory");
    float sv[16]; int ex[16];
#pragma unroll
    for (int j = 0; j < 16; ++j) { const unsigned k = top[j]; const int ci = (k >> 4) & 15, cj = k & 15;
        sv[j] = key2f(k & ~255u);
        const unsigned a = L[ci * 64 + lane], bq = L[(16 + cj) * 64 + lane];
        ex[j] = (127 - (int)(a & 127u)) * NKEYS + (127 - (int)(bq & 127u)); }
    float mx = sv[0], sum = 0.f;
#pragma unroll
    for (int j = 0; j < 16; ++j) { sv[j] = __builtin_amdgcn_exp2f((sv[j] - mx) * 1.4426950408889634f); sum += sv[j]; }
    const float inv = 1.0f / sum;
    GAS v4u* ip = (GAS v4u*)(F.IDX + (size_t)t * 128 + h * 16); GAS f32x4* gp = (GAS f32x4*)(F.GATE + (size_t)t * 128 + h * 16);
#pragma unroll
    for (int j = 0; j < 4; ++j) { ip[j] = (v4u){(unsigned)ex[4 * j], (unsigned)ex[4 * j + 1], (unsigned)ex[4 * j + 2], (unsigned)ex[4 * j + 3]};
        gp[j] = (f32x4){sv[4 * j] * inv, sv[4 * j + 1] * inv, sv[4 * j + 2] * inv, sv[4 * j + 3] * inv}; }
    LDS_WAIT(); asm volatile("" ::: "memory");
}

__device__ __forceinline__ float dot2bf(unsigned a, unsigned b, float acc) {
    typedef __bf16 b2 __attribute__((ext_vector_type(2)));
    return __builtin_amdgcn_fdot2_f32_bf16(__builtin_bit_cast(b2, a), __builtin_bit_cast(b2, b), acc, false);
}
__device__ __forceinline__ float gelu_erf(float v) {
    const float av = fabsf(v), t = __builtin_amdgcn_rcpf(av * 0.2316418882f + 1.0f);
    float q = t * 0.5307027145f + (-0.7265760135f); q = q * t + 0.7107068705f; q = q * t + (-0.142248368f); q = q * t + 0.127414796f; q = q * t;
    const float e = __builtin_amdgcn_exp2f((v * v) * (-0.72134752044f));
    const float m = v * (q * e);
    return v < 0.f ? m : v - m;
}
#define DPPF(v, ctrl) __builtin_bit_cast(float, __builtin_amdgcn_update_dpp(0, __builtin_bit_cast(int, (v)), (ctrl), 0xF, 0xF, true))
__device__ __forceinline__ float row16_sum(float v) {
    v += DPPF(v, 0xB1); v += DPPF(v, 0x4E); v += DPPF(v, 0x141); v += DPPF(v, 0x140); return v;
}
__device__ __forceinline__ float xgroup_sum(float v) {
    { auto r = __builtin_amdgcn_permlane16_swap(__float_as_uint(v), __float_as_uint(v), false, false); v = __uint_as_float(r[0]) + __uint_as_float(r[1]); }
    { auto r = __builtin_amdgcn_permlane32_swap(__float_as_uint(v), __float_as_uint(v), false, false); v = __uint_as_float(r[0]) + __uint_as_float(r[1]); }
    return v;
}
__device__ __forceinline__ float row8_sum(float v) {
    v += DPPF(v, 0xB1); v += DPPF(v, 0x4E); v += DPPF(v, 0x141); return v;
}
__device__ __forceinline__ float col8_sum(float v) {
    v += DPPF(v, 0x128);
    { auto r = __builtin_amdgcn_permlane16_swap(__float_as_uint(v), __float_as_uint(v), false, false); v = __uint_as_float(r[0]) + __uint_as_float(r[1]); }
    { auto r = __builtin_amdgcn_permlane32_swap(__float_as_uint(v), __float_as_uint(v), false, false); v = __uint_as_float(r[0]) + __uint_as_float(r[1]); }
    return v;
}
template <bool VPH>
__device__ __forceinline__ void peer_slice_phase(Frame& F) {
    const int lane = F.lane, r8 = lane >> 3, c8 = lane & 7;
    const int sl = (int)blockIdx.x & 7, rank = (int)blockIdx.x >> 3, nr = F.G >> 3;
    LAS int* Lidx = (LAS int*)(F.lds + RING_OFF + F.wave * 4096);
    LAS float* Lco = (LAS float*)(Lidx + 256);
    const unsigned char* tab = (VPH ? F.VTAB : F.UT) + ((size_t)sl << 21) + c8 * 16;
    const int tstride = nr * 8;
    int t = rank * 8 + F.wave;
    if (t >= T) return;
    v4u bufA[16], bufB[16]; v4u xA[2], xB[2]; int i0, i1; float g0 = 0.f, g1 = 0.f;
#define S_LOAD_IDX(tt) do { i0 = F.IDX[(size_t)(tt) * 128 + lane]; i1 = F.IDX[(size_t)(tt) * 128 + 64 + lane]; if (VPH) { g0 = F.GATE[(size_t)(tt) * 128 + lane]; g1 = F.GATE[(size_t)(tt) * 128 + 64 + lane]; } } while (0)
#define S_PUT_IDX(slot) do { Lidx[(slot) * 128 + lane] = i0; Lidx[(slot) * 128 + 64 + lane] = i1; if (VPH) { Lco[(slot) * 128 + lane] = g0; Lco[(slot) * 128 + 64 + lane] = g1; } LDS_WAIT(); asm volatile("" ::: "memory"); } while (0)
#define S_ISSUE(buf, xb, slot, tt) do { \
        _Pragma("unroll") for (int it = 0; it < 16; ++it) { const int e_ = Lidx[(slot) * 128 + it * 8 + r8]; buf[it] = *(const GAS v4u*)(tab + ((size_t)e_ << 7)); } \
        const GAS v4u* xp_ = (const GAS v4u*)(F.XB + (size_t)(tt) * D + sl * 128 + c8 * 16); xb[0] = xp_[0]; xb[1] = xp_[1]; } while (0)
#define S_CVT16(W_, f) do { const f32x2 q0_ = __builtin_amdgcn_cvt_pk_f32_fp8((W_).x, false), q1_ = __builtin_amdgcn_cvt_pk_f32_fp8((W_).x, true), q2_ = __builtin_amdgcn_cvt_pk_f32_fp8((W_).y, false), q3_ = __builtin_amdgcn_cvt_pk_f32_fp8((W_).y, true); \
        const f32x2 q4_ = __builtin_amdgcn_cvt_pk_f32_fp8((W_).z, false), q5_ = __builtin_amdgcn_cvt_pk_f32_fp8((W_).z, true), q6_ = __builtin_amdgcn_cvt_pk_f32_fp8((W_).w, false), q7_ = __builtin_amdgcn_cvt_pk_f32_fp8((W_).w, true); \
        f[0] = q0_.x; f[1] = q0_.y; f[2] = q1_.x; f[3] = q1_.y; f[4] = q2_.x; f[5] = q2_.y; f[6] = q3_.x; f[7] = q3_.y; f[8] = q4_.x; f[9] = q4_.y; f[10] = q5_.x; f[11] = q5_.y; f[12] = q6_.x; f[13] = q6_.y; f[14] = q7_.x; f[15] = q7_.y; } while (0)
#define S_XF(xb, xf) do { xf[0] = bflo(xb[0].x); xf[1] = bfhi(xb[0].x); xf[2] = bflo(xb[0].y); xf[3] = bfhi(xb[0].y); xf[4] = bflo(xb[0].z); xf[5] = bfhi(xb[0].z); xf[6] = bflo(xb[0].w); xf[7] = bfhi(xb[0].w); \
        xf[8] = bflo(xb[1].x); xf[9] = bfhi(xb[1].x); xf[10] = bflo(xb[1].y); xf[11] = bfhi(xb[1].y); xf[12] = bflo(xb[1].z); xf[13] = bfhi(xb[1].z); xf[14] = bflo(xb[1].w); xf[15] = bfhi(xb[1].w); } while (0)
#define S_COMPUTE(buf, xb, slot, tt) do { float xf[16]; S_XF(xb, xf); \
        if (!VPH) { \
            _Pragma("unroll") for (int it = 0; it < 16; ++it) { float f[16]; S_CVT16(buf[it], f); float d_ = 0.f; \
                _Pragma("unroll") for (int k = 0; k < 16; ++k) d_ += f[k] * xf[k]; \
                d_ = row8_sum(d_); if (c8 == 0) Lco[it * 8 + r8] = d_; } \
            LDS_WAIT(); asm volatile("" ::: "memory"); \
            const float d0_ = Lco[lane], d1_ = Lco[lane + 64]; \
            GAS float* pd_ = (GAS float*)(F.PD + ((size_t)(tt) * 8 + sl) * 128); pd_[lane] = d0_; pd_[lane + 64] = d1_; \
            LDS_WAIT(); asm volatile("" ::: "memory"); \
        } else { \
            float acc[16]; \
            _Pragma("unroll") for (int k = 0; k < 16; ++k) acc[k] = 0.f; \
            _Pragma("unroll") for (int it = 0; it < 16; ++it) { float f[16]; S_CVT16(buf[it], f); const float cf_ = Lco[(slot) * 128 + it * 8 + r8]; \
                _Pragma("unroll") for (int k = 0; k < 16; ++k) acc[k] += cf_ * f[k]; } \
            float s1_ = 0.f, s2_ = 0.f; \
            _Pragma("unroll") for (int k = 0; k < 16; ++k) { acc[k] = col8_sum(acc[k]) + ALPHA * xf[k]; s1_ += acc[k]; s2_ += acc[k] * acc[k]; } \
            s1_ = row8_sum(s1_); s2_ = row8_sum(s2_); \
            if (r8 < 4) { const f32x4 o_ = r8 == 0 ? (f32x4){acc[0], acc[1], acc[2], acc[3]} : r8 == 1 ? (f32x4){acc[4], acc[5], acc[6], acc[7]} : r8 == 2 ? (f32x4){acc[8], acc[9], acc[10], acc[11]} : (f32x4){acc[12], acc[13], acc[14], acc[15]}; \
                *(GAS f32x4*)(F.out + (size_t)(tt) * D + sl * 128 + c8 * 16 + r8 * 4) = o_; } \
            if (lane == 0) { GAS float* st_ = (GAS float*)(F.STATS + ((size_t)(tt) * 8 + sl) * 2); st_[0] = s1_; st_[1] = s2_; } \
        } } while (0)
    S_LOAD_IDX(t); S_PUT_IDX(0); S_ISSUE(bufA, xA, 0, t);
    int tn = t + tstride;
    if (tn < T) S_LOAD_IDX(tn);
#pragma unroll 1
    for (;;) {
        const bool hasB = tn < T;
        if (hasB) { S_PUT_IDX(1); S_ISSUE(bufB, xB, 1, tn); const int t2 = tn + tstride; if (t2 < T) S_LOAD_IDX(t2); }
        S_COMPUTE(bufA, xA, 0, t);
        if (!hasB) break;
        t = tn; tn = t + tstride;
        const bool hasA = tn < T;
        if (hasA) { S_PUT_IDX(0); S_ISSUE(bufA, xA, 0, tn); const int t2 = tn + tstride; if (t2 < T) S_LOAD_IDX(t2); }
        S_COMPUTE(bufB, xB, 1, t);
        if (!hasA) break;
        t = tn; tn = t + tstride;
    }
#undef S_LOAD_IDX
#undef S_PUT_IDX
#undef S_ISSUE
#undef S_CVT16
#undef S_XF
#undef S_COMPUTE
}
__device__ __forceinline__ void peer_coef_phase(Frame& F) {
    const size_t total = (size_t)T * 128, stride = (size_t)F.G * NWAVES * 64;
    for (size_t q = ((size_t)F.vcu * NWAVES + F.wave) * 64 + F.lane; q < total; q += stride) {
        const size_t t = q >> 7; const int j = (int)(q & 127);
        const GAS float* pd = (const GAS float*)(F.PD + t * 1024 + j);
        float d = 0.f;
#pragma unroll
        for (int sl = 0; sl < 8; ++sl) d += pd[sl * 128];
        const int e = F.IDX[q];
        F.GATE[q] = F.GATE[q] * gelu_erf(d * F.USC[e]) * F.VSC[e];
    }
}
__device__ __forceinline__ void ln2_row(Frame& F, int m) {
    GAS f32x4* zr = (GAS f32x4*)(F.out + (size_t)m * D) + F.lane;
    f32x4 v[4];
#pragma unroll
    for (int j = 0; j < 4; ++j) v[j] = zr[64 * j];
    const GAS float* st = (const GAS float*)(F.STATS + (size_t)m * 16);
    float s1 = 0.f, s2 = 0.f;
#pragma unroll
    for (int k = 0; k < 8; ++k) { s1 += st[2 * k]; s2 += st[2 * k + 1]; }
    const float mean = s1 * (1.f / D); const float var = fmaxf(s2 * (1.f / D) - mean * mean, 0.f);
    const float rstd = 1.f / sqrtf(var + LN_EPS);
#pragma unroll
    for (int j = 0; j < 4; ++j) { const f32x4 gg = *((const GAS f32x4*)F.ln2_g + F.lane + 64 * j), bb = *((const GAS f32x4*)F.ln2_b + F.lane + 64 * j);
        zr[64 * j] = (v[j] - mean) * rstd * gg + bb; }
}

struct Args { const float* in[21]; float* out; unsigned char* ws; int ph_lo, ph_hi, li, pad; };
__global__ void __launch_bounds__(NWAVES * 64, 2) fwd_kernel(Args args) {
    extern __shared__ __attribute__((aligned(16))) unsigned char lds[];
    Frame F;
    F.lds = (LAS unsigned char*)lds;
    F.MISC = (volatile LAS unsigned*)(F.lds + MISC_OFF);
    F.tid = threadIdx.x; F.lane = F.tid & 63; F.wave = __builtin_amdgcn_readfirstlane(F.tid >> 6);
    F.G = gridDim.x; { const int bx = blockIdx.x; F.vcu = (F.G % 8 == 0) ? (bx % 8) * (F.G / 8) + bx / 8 : bx; }
    unsigned char* ws = args.ws;
    F.ctl = (gu32*)(ws + WS_CTL);
    F.x = args.in[0]; F.w_in = args.in[1]; F.b_in = args.in[2]; F.cw_dw = args.in[3]; F.cb_dw = args.in[4]; F.cln_g = args.in[5]; F.cln_b = args.in[6];
    F.w_pw2 = args.in[7]; F.b_pw2 = args.in[8]; F.w_o = args.in[9]; F.w_out = args.in[10]; F.b_out = args.in[11]; F.ln1_g = args.in[12]; F.ln1_b = args.in[13];
    F.w_q = args.in[14]; F.keys1 = args.in[15]; F.keys2 = args.in[16]; F.pu = args.in[17]; F.pv = args.in[18]; F.ln2_g = args.in[19]; F.ln2_b = args.in[20];
    F.out = args.out;
    F.WinT = (bf16*)(ws + WS_WIN); F.WvT = (bf16*)(ws + WS_WV); F.Wpw2T = (bf16*)(ws + WS_WPW2); F.WoT = (bf16*)(ws + WS_WO); F.WoutT = (bf16*)(ws + WS_WOUT); F.WeffT = (bf16*)(ws + WS_WEFF);
    F.UT = ws + WS_UT; F.VTAB = ws + WS_VTAB; F.USC = (float*)(ws + WS_USC); F.VSC = (float*)(ws + WS_VSC); F.XB = (bf16*)(ws + WS_XB); F.Cb = (bf16*)(ws + WS_C); F.AO = (bf16*)(ws + WS_AO);
    F.GLU = (bf16*)(ws + WS_GLU); F.Qb = (bf16*)(ws + WS_Q); F.Kb = (bf16*)(ws + WS_K); F.VT = (bf16*)(ws + WS_VT); F.M2 = (bf16*)(ws + WS_M2); F.Gt = (bf16*)(ws + WS_G);
    F.R = (float*)(ws + WS_R); F.ST = (float*)(ws + WS_ST); F.GATE = (float*)(ws + WS_GATE); F.IDX = (int*)(ws + WS_IDX); F.PD = (float*)(ws + WS_PD); F.STATS = (float*)(ws + WS_STATS);
    for (int u = F.tid; u < (LDS_BYTES - LDSCTL_OFF) / 4; u += NWAVES * 64) ((LAS unsigned*)(F.lds + LDSCTL_OFF))[u] = 0u;
    __syncthreads();
    XcdBarrier bar; bar.bar = (unsigned*)(F.ctl + CW_BAR); bar.x = 0; bar.st = nullptr;
    if (MK_N_LAUNCHES == 1) bar = xcd_barrier_post((unsigned*)(F.ctl + CW_BAR), F.MISC + 8);
#define GRID_BAR() do { if (MK_N_LAUNCHES == 1) xcd_barrier(bar); } while (0)
    const int lo = args.ph_lo, hi = args.ph_hi;
#ifdef ONLY_PHASE
#define IN(k) ((k) == ONLY_PHASE && lo <= (k) && (k) < hi)
#elif defined(DBG_STOP)
#define IN(k) ((k) <= DBG_STOP && lo <= (k) && (k) < hi)
#else
#define IN(k) (lo <= (k) && (k) < hi)
#endif
#define BOTH(k) (IN(k) && IN((k) + 1))
    const int gw = F.vcu * NWAVES + F.wave, NGW = F.G * NWAVES;

    if (IN(0)) { for (int rep = 0; rep <= REP(0); ++rep) p0_prologue(F); if (BOTH(0)) GRID_BAR(); }

    if (IN(1)) {
        for (int rep = 0; rep <= REP(1); ++rep) {
        { pg8::Gemm g{F.XB, F.WinT, T, NIN, D, D, D}; pg8::StaticOrder S; S.init(T, NIN, F.G, (int)blockIdx.x);
          pg8::EpiIn E{F.b_in, F.GLU, F.Qb, F.Kb, F.Gt, QSCALE};
          pg8::gemm_phase<pg8::EpiIn, pg8::StaticOrder, true, true>(F.lds + RING_OFF, g, S, E); }
        { pg8::Gemm g{F.WvT, F.XB, SBDIM, T, D, D, D}; pg8::StaticOrder S; S.init(SBDIM, T, F.G, (int)blockIdx.x);
          pg8::EpiVT E{F.b_in + 2048, F.VT, T};
          __syncthreads();
          pg8::gemm_phase<pg8::EpiVT, pg8::StaticOrder, false, true>(F.lds + RING_OFF, g, S, E); }
        }
        if (BOTH(1)) GRID_BAR();
    }

    if (IN(2)) {
        for (int rep = 0; rep <= REP(2); ++rep) {
        for (int ct = F.vcu; ct < T / 64; ct += F.G) conv_unit(F, ct);
        for (int task = gw; task < BATCH * SBH * (SEQ / 32); task += NGW) attn_task(F, task);
        }
        if (BOTH(2)) GRID_BAR();
    }

    if (IN(3)) {
        for (int rep = 0; rep <= REP(3); ++rep) {
        { pg8::Gemm g{F.Cb, F.Wpw2T, T, D, CONVD, CONVD, CONVD}; pg8::StaticOrder S; S.init(T, D, F.G, (int)blockIdx.x);
          pg8::EpiGate<false> E{F.b_pw2, F.Gt, F.M2, 0};
          pg8::gemm_phase<pg8::EpiGate<false>, pg8::StaticOrder, true, true>(F.lds + RING_OFF, g, S, E); }
        { pg8::Gemm g{F.AO, F.WoT, T, D, SBDIM, SBDIM, SBDIM}; pg8::StaticOrder S; S.init(T, D, F.G, (int)blockIdx.x);
          pg8::EpiGate<true> E{nullptr, F.Gt, F.M2, 1024};
          pg8::gemm_phase<pg8::EpiGate<true>, pg8::StaticOrder, true, true>(F.lds + RING_OFF, g, S, E); }
        }
        if (BOTH(3)) GRID_BAR();
    }

    if (IN(4)) {
        for (int rep = 0; rep <= REP(4); ++rep) {
        pg8::Gemm g{F.M2, F.WoutT, T, D, D, D, D}; pg8::StaticOrder S; S.init(T, D, F.G, (int)blockIdx.x);
        pg8::EpiRes E{F.R, F.x, F.b_out, ALPHA, D};
        pg8::gemm_phase<pg8::EpiRes, pg8::StaticOrder, true, true>(F.lds + RING_OFF, g, S, E);
        }
        if (BOTH(4)) GRID_BAR();
    }

    if (IN(5)) {
        for (int rep = 0; rep <= REP(5); ++rep)
        for (int m = gw; m < T; m += NGW) ln1_row(F, m);
        if (BOTH(5)) GRID_BAR();
    }

    if (IN(6)) {
        for (int rep = 0; rep <= REP(6); ++rep) {
        pg8::Gemm g{F.WeffT, F.XB, 2048, T, D, D, D}; pg8::StaticOrder S; S.init(2048, T, F.G, (int)blockIdx.x);
        pg8::EpiF16 E{(unsigned short*)F.ST, T};
        pg8::gemm_phase<pg8::EpiF16, pg8::StaticOrder, true, true>(F.lds + RING_OFF, g, S, E);
        }
        if (BOTH(6)) GRID_BAR();
    }

    if (IN(7)) {
        for (int rep = 0; rep <= REP(7); ++rep)
        for (int task = gw; task < (T / 64) * PH; task += NGW) select_task(F, task);
        if (BOTH(7)) GRID_BAR();
    }

    if (IN(8)) {
        for (int rep = 0; rep <= REP(8); ++rep) peer_slice_phase<false>(F);
        if (BOTH(8)) GRID_BAR();
    }
    if (IN(9)) {
        peer_coef_phase(F);
        if (BOTH(9)) GRID_BAR();
    }
    if (IN(10)) {
        for (int rep = 0; rep <= REP(10); ++rep) peer_slice_phase<true>(F);
        if (BOTH(10)) GRID_BAR();
    }
    if (IN(11)) {
        for (int rep = 0; rep <= REP(11); ++rep)
        for (int m = gw; m < T; m += NGW) ln2_row(F, m);
    }
#ifdef DBG_STOP
    if (lo <= 11 && 11 < hi) {
        GRID_BAR();
        { const unsigned long long t0 = __builtin_amdgcn_s_memrealtime(); while (__builtin_amdgcn_s_memrealtime() - t0 < 30000ull) __builtin_amdgcn_s_sleep(32); }
        GRID_BAR();
        const size_t n4 = (size_t)T * D / 4;
        for (size_t i = (size_t)gw * 64 + F.lane; i < n4; i += (size_t)NGW * 64) {
            f32x4 v = (f32x4){0.f, 0.f, 0.f, 0.f};
            if (DBG_STOP == 4) { v = ((const GAS f32x4*)F.R)[i]; v = (f32x4){bflo(f2bf(v.x)), bflo(f2bf(v.y)), bflo(f2bf(v.z)), bflo(f2bf(v.w))}; }
            else if (DBG_STOP == 3) { const v2u w = ((const GAS v2u*)F.M2)[i]; const v2u w2 = ((const GAS v2u*)F.M2)[i + n4]; v = (f32x4){bflo(w.x) + bflo(w2.x), bfhi(w.x) + bfhi(w2.x), bflo(w.y) + bflo(w2.y), bfhi(w.y) + bfhi(w2.y)}; }
            else if (DBG_STOP == 2) { const size_t r = i / 256, c4 = i % 256; const bf16* src = (c4 < 128) ? F.Cb + r * 512 + c4 * 4 : F.AO + r * 512 + (c4 - 128) * 4; const v2u w = *(const GAS v2u*)src; v = (f32x4){bflo(w.x), bfhi(w.x), bflo(w.y), bfhi(w.y)}; }
            else if (DBG_STOP == 1) { const v2u w = ((const GAS v2u*)F.Gt)[i]; v = (f32x4){bflo(w.x), bfhi(w.x), bflo(w.y), bfhi(w.y)}; }
            else if (DBG_STOP == 5) { const v2u w = ((const GAS v2u*)F.XB)[i]; v = (f32x4){bflo(w.x), bfhi(w.x), bflo(w.y), bfhi(w.y)}; }
            else if (DBG_STOP == 6) v = ((const GAS f32x4*)F.ST)[i] + ((const GAS f32x4*)F.ST)[i + n4];
            else if (DBG_STOP == 7) { if (i < (size_t)T * 32) { const v4u w = ((const GAS v4u*)F.IDX)[i]; v = (f32x4){(float)w.x, (float)w.y, (float)w.z, (float)w.w}; } else if (i < (size_t)T * 64) v = ((const GAS f32x4*)F.GATE)[i - (size_t)T * 32]; }
            ((GAS f32x4*)F.out)[i] = v; }
    }
#endif
#undef IN
#undef BOTH
}

extern "C" void kernel_launch(void* const* d_in, const int* in_sizes, int n_in, void* d_out, int out_size, void* d_ws, size_t ws_size, hipStream_t stream) {
    static int grid = 0;
    if (grid == 0) {
        if (n_in != 21 || in_sizes[0] != T * D || out_size != T * D || ws_size < WS_END) { fprintf(stderr, "kernel_launch: unexpected shapes (n_in %d, in0 %d, out %d, ws %zu); nothing launched\n", n_in, n_in > 0 ? in_sizes[0] : -1, out_size, ws_size); grid = -1; return; }
        int dev = 0, cus = 0, per_cu = 0;
        if (hipGetDevice(&dev) != hipSuccess || hipDeviceGetAttribute(&cus, hipDeviceAttributeMultiprocessorCount, dev) != hipSuccess) { grid = -1; return; }
        if (hipFuncSetAttribute((const void*)fwd_kernel, hipFuncAttributeMaxDynamicSharedMemorySize, LDS_BYTES) != hipSuccess) { fprintf(stderr, "kernel_launch: hipFuncSetAttribute failed\n"); grid = -1; return; }
        if (hipOccupancyMaxActiveBlocksPerMultiprocessor(&per_cu, (const void*)fwd_kernel, NWAVES * 64, LDS_BYTES) != hipSuccess || per_cu < 1)
            fprintf(stderr, "kernel_launch: note: occupancy query reports %d workgroups per CU\n", per_cu);
        (void)hipGetLastError();
        grid = cus;
    }
    if (grid < 0) return;
    if (hipMemsetAsync((char*)d_ws + WS_CTL, 0, CTL_ZERO_BYTES, stream) != hipSuccess) return;
    Args a{};
    for (int i = 0; i < 21; ++i) a.in[i] = (const float*)d_in[i];
    a.out = (float*)d_out; a.ws = (unsigned char*)d_ws;
    for (int li = 0; li < MK_N_LAUNCHES; ++li) {
        a.ph_lo = (MK_N_LAUNCHES == 1) ? 0 : li; a.ph_hi = (MK_N_LAUNCHES == 1) ? N_PHASES : li + 1; a.li = li;
        hipLaunchKernelGGL(fwd_kernel, dim3(grid), dim3(NWAVES * 64), LDS_BYTES, stream, a);
    }
}
```

```cpp
#include <hip/hip_runtime.h>
#include <hip/hip_bf16.h>
#include <cstdio>
#include <cstdint>
#include <cmath>

#ifndef REPEAT_MASK
#define REPEAT_MASK 0
#endif
#define REP(k) ((REPEAT_MASK >> (k)) & 1)
#ifndef MK_N_LAUNCHES
#define MK_N_LAUNCHES 1
#endif

namespace pg8 {
#define PG8_LAS __attribute__((address_space(3)))
typedef unsigned short bf16_t;
typedef short bf16x8 __attribute__((ext_vector_type(8)));
typedef float f32x4 __attribute__((ext_vector_type(4)));
typedef unsigned u32x4 __attribute__((ext_vector_type(4)));
constexpr int BM = 256, BK = 64, HALF = 128, HTB = HALF * BK * 2, STAGE_BYTES = 8 * HTB, NXCD = 8, WGM = 8;

__host__ __device__ __forceinline__ int lds_byte(int r, int c) { const int st = (r >> 4) * 2 + (c >> 5), rr = r & 15, cc = c & 31, ob = rr * 64 + cc * 2; return st * 1024 + (ob ^ (((ob >> 9) & 1) << 5)); }
__host__ __device__ __forceinline__ void stage_rc(int b, int& R, int& C) { const int st = b / 1024, sb = b % 1024, swz = sb ^ (((sb >> 9) & 1) << 5); R = (st >> 1) * 16 + swz / 64; C = (st & 1) * 32 + (swz % 64) / 2; }
__host__ __device__ __forceinline__ int perm32(int rho) { const int n = rho >> 4, i = rho & 15; return 8 * (i >> 2) + 4 * n + (i & 3); }

struct Unit { int pm, pn; };
struct Gemm { const bf16_t* A; const bf16_t* Bt; int M, N, K, lda, ldb; };

struct StaticOrder {
    int nM, nN, nwg, G, c;
    __host__ __device__ void init(int M, int N, int G_, int c_) { nM = M / BM; nN = N / BM; nwg = nM * nN; G = G_; c = c_; }
    __host__ __device__ bool next(int i, Unit& u) const {
        const long L = (long)i * G + c; if (L >= nwg) return false;
        int wgid = (int)L; { const int q = nwg / NXCD, r = nwg % NXCD, xcd = wgid % NXCD, off = wgid / NXCD; wgid = (xcd < r ? xcd * (q + 1) : r * (q + 1) + (xcd - r) * q) + off; }
        const int nig = WGM * nN, gid = wgid / nig, fm = gid * WGM, gsz = (nM - fm) < WGM ? (nM - fm) : WGM;
        u.pm = fm + ((wgid % nig) % gsz); u.pn = (wgid % nig) / gsz; return true;
    }
    __device__ __forceinline__ void a_ready(const Unit&) const {}
    __device__ __forceinline__ void done(const Unit&) const {}
};

__device__ __forceinline__ unsigned cvt_pk_bf16(float lo, float hi) { typedef float f2_t __attribute__((ext_vector_type(2))); typedef __bf16 b2_t __attribute__((ext_vector_type(2))); f2_t v = {lo, hi}; b2_t b = __builtin_convertvector(v, b2_t); return __builtin_bit_cast(unsigned, b); }
__device__ __forceinline__ float sigmoid_f(float x) { return __builtin_amdgcn_rcpf(1.0f + __builtin_amdgcn_exp2f(-1.4426950408889634f * x)); }

struct EpiF32 {
    static constexpr bool PERM = false, AFTER_DRAIN = false;
    float* C; int ldc;
    __device__ __forceinline__ void operator()(const f32x4 (&acc)[2][2][4][2], const Unit& u, int wr, int wc, int fr, int fq) const {
        const int row0 = u.pm * BM + wr * 64 + fr, col0 = u.pn * BM + wc * 32 + 4 * fq;
#pragma unroll
        for (int ai = 0; ai < 2; ++ai)
#pragma unroll
            for (int m = 0; m < 4; ++m) { float* rowp = C + (size_t)(row0 + ai * HALF + m * 16) * ldc + col0;
#pragma unroll
                for (int bj = 0; bj < 2; ++bj)
#pragma unroll
                    for (int n = 0; n < 2; ++n) *(f32x4*)(rowp + bj * HALF + n * 16) = acc[ai][bj][m][n]; }
    }
};
struct EpiRes {
    static constexpr bool PERM = false, AFTER_DRAIN = false;
    float* C; const float* X; const float* bias; float alpha; int ldc;
    __device__ __forceinline__ void operator()(const f32x4 (&acc)[2][2][4][2], const Unit& u, int wr, int wc, int fr, int fq) const {
        const int row0 = u.pm * BM + wr * 64 + fr, col0 = u.pn * BM + wc * 32 + 4 * fq;
        f32x4 bv[2][2];
#pragma unroll
        for (int bj = 0; bj < 2; ++bj)
#pragma unroll
            for (int n = 0; n < 2; ++n) bv[bj][n] = *(const f32x4*)(bias + col0 + bj * HALF + n * 16);
#pragma unroll
        for (int ai = 0; ai < 2; ++ai)
#pragma unroll
            for (int m = 0; m < 4; ++m) { const size_t off = (size_t)(row0 + ai * HALF + m * 16) * ldc + col0;
#pragma unroll
                for (int bj = 0; bj < 2; ++bj)
#pragma unroll
                    for (int n = 0; n < 2; ++n) { const f32x4 xv = *(const f32x4*)(X + off + bj * HALF + n * 16);
                        *(f32x4*)(C + off + bj * HALF + n * 16) = acc[ai][bj][m][n] + bv[bj][n] + xv * alpha; } }
    }
};
struct EpiIn {
    static constexpr bool PERM = true, AFTER_DRAIN = false;
    const float* b_in; bf16_t* GLU; bf16_t* Q; bf16_t* Kb; bf16_t* G; float qscale;
    __device__ __forceinline__ void operator()(const f32x4 (&acc)[2][2][4][2], const Unit& u, int wr, int wc, int fr, int fq) const {
        const int row0 = u.pm * BM + wr * 64 + fr; const int cw = wc * 32 + 8 * fq;
        if (u.pn < 4) {
            const int oc = u.pn * 128 + cw;
            const f32x4 ba0 = *(const f32x4*)(b_in + oc), ba1 = *(const f32x4*)(b_in + oc + 4), bg0 = *(const f32x4*)(b_in + 512 + oc), bg1 = *(const f32x4*)(b_in + 512 + oc + 4);
#pragma unroll
            for (int ai = 0; ai < 2; ++ai)
#pragma unroll
                for (int m = 0; m < 4; ++m) { const size_t row = (size_t)(row0 + ai * HALF + m * 16);
                    const f32x4 a0 = acc[ai][0][m][0] + ba0, a1 = acc[ai][0][m][1] + ba1, g0 = acc[ai][1][m][0] + bg0, g1 = acc[ai][1][m][1] + bg1;
                    u32x4 w;
                    w.x = cvt_pk_bf16(a0[0] * sigmoid_f(g0[0]), a0[1] * sigmoid_f(g0[1])); w.y = cvt_pk_bf16(a0[2] * sigmoid_f(g0[2]), a0[3] * sigmoid_f(g0[3]));
                    w.z = cvt_pk_bf16(a1[0] * sigmoid_f(g1[0]), a1[1] * sigmoid_f(g1[1])); w.w = cvt_pk_bf16(a1[2] * sigmoid_f(g1[2]), a1[3] * sigmoid_f(g1[3]));
                    *(u32x4*)(GLU + row * 512 + oc) = w; }
        } else if (u.pn < 8) {
            const int which = (u.pn - 4) >> 1; bf16_t* base = which ? Kb : Q; const float sc = which ? 1.0f : qscale;
#pragma unroll
            for (int bj = 0; bj < 2; ++bj) { const int cwithin = ((u.pn - 4) & 1) * 256 + bj * HALF + cw; const int ocol = 1024 + which * 512 + cwithin;
                const f32x4 b0 = *(const f32x4*)(b_in + ocol), b1 = *(const f32x4*)(b_in + ocol + 4);
#pragma unroll
                for (int ai = 0; ai < 2; ++ai)
#pragma unroll
                    for (int m = 0; m < 4; ++m) { const size_t row = (size_t)(row0 + ai * HALF + m * 16);
                        const f32x4 v0 = (acc[ai][bj][m][0] + b0) * sc, v1 = (acc[ai][bj][m][1] + b1) * sc;
                        u32x4 w; w.x = cvt_pk_bf16(v0[0], v0[1]); w.y = cvt_pk_bf16(v0[2], v0[3]); w.z = cvt_pk_bf16(v1[0], v1[1]); w.w = cvt_pk_bf16(v1[2], v1[3]);
                        *(u32x4*)(base + row * 512 + cwithin) = w; } }
        } else {
#pragma unroll
            for (int bj = 0; bj < 2; ++bj) { const int gcol = (u.pn - 8) * 256 + bj * HALF + cw; const int ocol = 2560 + gcol;
                const f32x4 b0 = *(const f32x4*)(b_in + ocol), b1 = *(const f32x4*)(b_in + ocol + 4);
#pragma unroll
                for (int ai = 0; ai < 2; ++ai)
#pragma unroll
                    for (int m = 0; m < 4; ++m) { const size_t row = (size_t)(row0 + ai * HALF + m * 16);
                        const f32x4 v0 = acc[ai][bj][m][0] + b0, v1 = acc[ai][bj][m][1] + b1;
#ifdef DBG_NOSIG
                        u32x4 w; w.x = cvt_pk_bf16(v0[0], v0[1]); w.y = cvt_pk_bf16(v0[2], v0[3]); w.z = cvt_pk_bf16(v1[0], v1[1]); w.w = cvt_pk_bf16(v1[2], v1[3]);
#else
                        u32x4 w; w.x = cvt_pk_bf16(sigmoid_f(v0[0]), sigmoid_f(v0[1])); w.y = cvt_pk_bf16(sigmoid_f(v0[2]), sigmoid_f(v0[3]));
                        w.z = cvt_pk_bf16(sigmoid_f(v1[0]), sigmoid_f(v1[1])); w.w = cvt_pk_bf16(sigmoid_f(v1[2]), sigmoid_f(v1[3]));
#endif
                        *(u32x4*)(G + row * 2048 + gcol) = w; } }
        }
    }
};
struct EpiVT {
    static constexpr bool PERM = true, AFTER_DRAIN = false;
    const float* rbias; bf16_t* O; int ldc;
    __device__ __forceinline__ void operator()(const f32x4 (&acc)[2][2][4][2], const Unit& u, int wr, int wc, int fr, int fq) const {
        const int row0 = u.pm * BM + wr * 64 + fr; const int col0 = u.pn * BM + wc * 32 + 8 * fq;
#pragma unroll
        for (int ai = 0; ai < 2; ++ai)
#pragma unroll
            for (int m = 0; m < 4; ++m) { const int row = row0 + ai * HALF + m * 16; const float rb = rbias[row];
#pragma unroll
                for (int bj = 0; bj < 2; ++bj) { const f32x4 v0 = acc[ai][bj][m][0] + rb, v1 = acc[ai][bj][m][1] + rb;
                    u32x4 w; w.x = cvt_pk_bf16(v0[0], v0[1]); w.y = cvt_pk_bf16(v0[2], v0[3]); w.z = cvt_pk_bf16(v1[0], v1[1]); w.w = cvt_pk_bf16(v1[2], v1[3]);
                    *(u32x4*)(O + (size_t)row * ldc + col0 + bj * HALF) = w; } }
    }
};
template <bool ADD> struct EpiGate {
    static constexpr bool PERM = true, AFTER_DRAIN = false;
    const float* bias; const bf16_t* Gt; bf16_t* O; int gcol0;
    __device__ __forceinline__ void operator()(const f32x4 (&acc)[2][2][4][2], const Unit& u, int wr, int wc, int fr, int fq) const {
        const int row0 = u.pm * BM + wr * 64 + fr; const int col0 = u.pn * BM + wc * 32 + 8 * fq;
#pragma unroll
        for (int bj = 0; bj < 2; ++bj) { const int c = col0 + bj * HALF;
            f32x4 b0 = (f32x4){0.f, 0.f, 0.f, 0.f}, b1 = b0; if (bias) { b0 = *(const f32x4*)(bias + c); b1 = *(const f32x4*)(bias + c + 4); }
#pragma unroll
            for (int ai = 0; ai < 2; ++ai)
#pragma unroll
                for (int m = 0; m < 4; ++m) { const size_t row = (size_t)(row0 + ai * HALF + m * 16);
                    const u32x4 gw = *(const u32x4*)(Gt + row * 2048 + gcol0 + c);
                    f32x4 v0 = acc[ai][bj][m][0] + b0, v1 = acc[ai][bj][m][1] + b1;
                    v0[0] *= __uint_as_float(gw.x << 16); v0[1] *= __uint_as_float(gw.x & 0xffff0000u); v0[2] *= __uint_as_float(gw.y << 16); v0[3] *= __uint_as_float(gw.y & 0xffff0000u);
                    v1[0] *= __uint_as_float(gw.z << 16); v1[1] *= __uint_as_float(gw.z & 0xffff0000u); v1[2] *= __uint_as_float(gw.w << 16); v1[3] *= __uint_as_float(gw.w & 0xffff0000u);
                    if (ADD) { const u32x4 pw = *(const u32x4*)(O + row * 1024 + c);
                        v0[0] += __uint_as_float(pw.x << 16); v0[1] += __uint_as_float(pw.x & 0xffff0000u); v0[2] += __uint_as_float(pw.y << 16); v0[3] += __uint_as_float(pw.y & 0xffff0000u);
                        v1[0] += __uint_as_float(pw.z << 16); v1[1] += __uint_as_float(pw.z & 0xffff0000u); v1[2] += __uint_as_float(pw.w << 16); v1[3] += __uint_as_float(pw.w & 0xffff0000u); }
                    u32x4 w; w.x = cvt_pk_bf16(v0[0], v0[1]); w.y = cvt_pk_bf16(v0[2], v0[3]); w.z = cvt_pk_bf16(v1[0], v1[1]); w.w = cvt_pk_bf16(v1[2], v1[3]);
                    *(u32x4*)(O + row * 1024 + c) = w; } }
    }
};
struct EpiF16 {
    static constexpr bool PERM = true, AFTER_DRAIN = false;
    unsigned short* C; int ldc;
    __device__ __forceinline__ unsigned pkh(float a, float b) const { typedef float f2_t __attribute__((ext_vector_type(2))); typedef _Float16 h2_t __attribute__((ext_vector_type(2))); f2_t v = {a, b}; h2_t h = __builtin_convertvector(v, h2_t); return __builtin_bit_cast(unsigned, h); }
    __device__ __forceinline__ void operator()(const f32x4 (&acc)[2][2][4][2], const Unit& u, int wr, int wc, int fr, int fq) const {
        const int row0 = u.pm * BM + wr * 64 + fr, col0 = u.pn * BM + wc * 32 + 8 * fq;
#pragma unroll
        for (int ai = 0; ai < 2; ++ai)
#pragma unroll
            for (int m = 0; m < 4; ++m) { unsigned short* rowp = C + (size_t)(row0 + ai * HALF + m * 16) * ldc + col0;
#pragma unroll
                for (int bj = 0; bj < 2; ++bj) { const f32x4 v0 = acc[ai][bj][m][0], v1 = acc[ai][bj][m][1];
                    u32x4 w; w.x = pkh(v0[0], v0[1]); w.y = pkh(v0[2], v0[3]); w.z = pkh(v1[0], v1[1]); w.w = pkh(v1[2], v1[3]);
                    *(u32x4*)(rowp + bj * HALF) = w; } }
    }
};

template <class Epi, class Sched, bool ALIGN_EPI = false, bool SP2 = false>
__device__ __forceinline__ void gemm_phase(PG8_LAS unsigned char* lds, const Gemm g, const Sched& S, const Epi& E) {
    const int tid = threadIdx.x, wid = __builtin_amdgcn_readfirstlane(tid >> 6), lane = tid & 63, wr = wid >> 2, wc = wid & 3, fr = lane & 15, fq = lane >> 4;
    const int K = g.K, nt = K / BK;
    unsigned voffA[2], voffB[2];
#pragma unroll
    for (int i = 0; i < 2; ++i) { int R, C; stage_rc(tid * 16 + i * 8192, R, C); const int Rb = Epi::PERM ? ((R & ~31) + perm32(R & 31)) : R;
        voffA[i] = (unsigned)(R * g.lda + C) * 2u; voffB[i] = (unsigned)(Rb * g.ldb + C) * 2u; }
    const size_t kstep = (size_t)(BK * 2);
    const size_t hstepA = (size_t)HALF * g.lda * 2, hstepB = (size_t)HALF * g.ldb * 2;
    const size_t tstepA = 2 * hstepA, tstepB = 2 * hstepB;
    const unsigned ldsw = (unsigned)wid * 1024u;
    const int aoff = lds_byte(wr * 64 + fr, fq * 8), boff = lds_byte(wc * 32 + fr, fq * 8);
#define PG8_SA(b, h) (((b) * 2 + (h)) * HTB)
#define PG8_SB(b, h) ((4 + (b) * 2 + (h)) * HTB)
#define PG8_STAGE(bufoff, gbase, voff) do { _Pragma("unroll") for (int _i = 0; _i < 2; ++_i) \
        __builtin_amdgcn_global_load_lds((const unsigned*)((const char*)(gbase) + (voff)[_i]), (PG8_LAS unsigned*)(lds + (bufoff) + ldsw + _i * 8192), 16, 0, 0); } while (0)
#define PG8_LDA(dst, b, h) do { _Pragma("unroll") for (int m = 0; m < 4; ++m) _Pragma("unroll") for (int k = 0; k < 2; ++k) dst[m][k] = *(const PG8_LAS bf16x8*)(lds + PG8_SA(b, h) + aoff + m * 2048 + k * 1024); } while (0)
#define PG8_LDB(dst, b, h) do { _Pragma("unroll") for (int n = 0; n < 2; ++n) _Pragma("unroll") for (int k = 0; k < 2; ++k) dst[n][k] = *(const PG8_LAS bf16x8*)(lds + PG8_SB(b, h) + boff + n * 2048 + k * 1024); } while (0)
#define PG8_MMA(ai, bj, At, Bt) do { __builtin_amdgcn_s_setprio(1); _Pragma("unroll") for (int m = 0; m < 4; ++m) _Pragma("unroll") for (int n = 0; n < 2; ++n) _Pragma("unroll") for (int k = 0; k < 2; ++k) \
        acc[ai][bj][m][n] = __builtin_amdgcn_mfma_f32_16x16x32_bf16(Bt[n][k], At[m][k], acc[ai][bj][m][n], 0, 0, 0); __builtin_amdgcn_s_setprio(0); } while (0)
#define PG8_WAIT_V(n) asm volatile("s_waitcnt vmcnt(" #n ")" ::: "memory")
#define PG8_WAIT_L(n) asm volatile("s_waitcnt lgkmcnt(" #n ")" ::: "memory")
#define PG8_BAR __builtin_amdgcn_s_barrier()
#define PG8_SCHED __builtin_amdgcn_sched_barrier(0)
    Unit cur, nxt; int ui = 0;
    if (!S.next(0, cur)) return;
    f32x4 acc[2][2][4][2];
#pragma unroll
    for (int a = 0; a < 2; ++a)
#pragma unroll
        for (int b = 0; b < 2; ++b)
#pragma unroll
            for (int m = 0; m < 4; ++m)
#pragma unroll
                for (int n = 0; n < 2; ++n) acc[a][b][m][n] = (f32x4){0.f, 0.f, 0.f, 0.f};
    bf16x8 At[4][2], B0[2][2], B1[2][2];
    const char* cA = (const char*)g.A + (size_t)cur.pm * tstepA; const char* cB = (const char*)g.Bt + (size_t)cur.pn * tstepB;
    S.a_ready(cur);
    if constexpr (SP2) {
        PG8_STAGE(PG8_SB(0, 0), cB, voffB); PG8_STAGE(PG8_SB(0, 1), cB + hstepB, voffB); PG8_STAGE(PG8_SA(0, 0), cA, voffA); PG8_STAGE(PG8_SA(0, 1), cA + hstepA, voffA);
        if (wr == 1) PG8_BAR;
        PG8_WAIT_V(2); PG8_BAR;
        PG8_STAGE(PG8_SB(1, 0), cB + kstep, voffB); PG8_STAGE(PG8_SA(1, 0), cA + kstep, voffA); PG8_STAGE(PG8_SB(1, 1), cB + hstepB + kstep, voffB);
        PG8_WAIT_V(6); PG8_BAR;
    } else {
        PG8_STAGE(PG8_SB(0, 0), cB, voffB); PG8_STAGE(PG8_SA(0, 0), cA, voffA); PG8_STAGE(PG8_SB(0, 1), cB + hstepB, voffB); PG8_STAGE(PG8_SA(0, 1), cA + hstepA, voffA);
        if (wr == 1) PG8_BAR;
        PG8_WAIT_V(4); PG8_BAR;
        PG8_STAGE(PG8_SB(1, 0), cB + kstep, voffB); PG8_STAGE(PG8_SA(1, 0), cA + kstep, voffA); PG8_STAGE(PG8_SB(1, 1), cB + hstepB + kstep, voffB);
        PG8_WAIT_V(6); PG8_BAR;
    }
    for (;;) {
        const bool has_next = S.next(ui + 1, nxt);
        const char* nA = has_next ? (const char*)g.A + (size_t)nxt.pm * tstepA : cA; const char* nB = has_next ? (const char*)g.Bt + (size_t)nxt.pn * tstepB : cB;
        for (int t = 0; t < nt; t += 2) {
            const bool last = (t == nt - 2);
            const char* a1 = cA + (size_t)(t + 1) * kstep;
            const char* a2 = last ? nA : cA + (size_t)(t + 2) * kstep; const char* b2 = last ? nB : cB + (size_t)(t + 2) * kstep;
            const char* a3 = a2 + kstep; const char* b3 = b2 + kstep;
            if (last && has_next) S.a_ready(nxt);
            if constexpr (SP2) {
            PG8_LDB(B0, 0, 0); PG8_LDB(B1, 0, 1); PG8_SCHED; PG8_LDA(At, 0, 0); PG8_STAGE(PG8_SA(1, 1), a1 + hstepA, voffA);
            PG8_WAIT_V(8); PG8_WAIT_L(0); PG8_BAR; PG8_MMA(0, 0, At, B0); PG8_MMA(0, 1, At, B1); PG8_BAR; PG8_SCHED;
            PG8_LDA(At, 0, 1); PG8_STAGE(PG8_SB(0, 0), b2, voffB); PG8_STAGE(PG8_SB(0, 1), b2 + hstepB, voffB); PG8_STAGE(PG8_SA(0, 0), a2, voffA);
            PG8_WAIT_V(8); PG8_WAIT_L(0); PG8_BAR; PG8_MMA(1, 0, At, B0); PG8_MMA(1, 1, At, B1); PG8_BAR; PG8_SCHED;
            PG8_LDB(B0, 1, 0); PG8_LDB(B1, 1, 1); PG8_SCHED; PG8_LDA(At, 1, 0); PG8_STAGE(PG8_SA(0, 1), a2 + hstepA, voffA);
            PG8_WAIT_V(8); PG8_WAIT_L(0); PG8_BAR; PG8_MMA(0, 0, At, B0); PG8_MMA(0, 1, At, B1); PG8_BAR; PG8_SCHED;
            PG8_LDA(At, 1, 1); PG8_STAGE(PG8_SB(1, 0), b3, voffB); PG8_STAGE(PG8_SB(1, 1), b3 + hstepB, voffB); PG8_STAGE(PG8_SA(1, 0), a3, voffA);
            PG8_WAIT_V(8); PG8_WAIT_L(0); PG8_BAR; PG8_MMA(1, 0, At, B0); PG8_MMA(1, 1, At, B1); PG8_BAR; PG8_SCHED;
            } else {
            PG8_LDB(B0, 0, 0); PG8_SCHED; PG8_LDA(At, 0, 0); PG8_STAGE(PG8_SA(1, 1), a1 + hstepA, voffA);
            PG8_WAIT_L(8); PG8_BAR; PG8_WAIT_L(0); PG8_MMA(0, 0, At, B0); PG8_BAR; PG8_SCHED;
            PG8_LDB(B1, 0, 1); PG8_STAGE(PG8_SB(0, 0), b2, voffB);
            PG8_BAR; PG8_WAIT_L(0); PG8_MMA(0, 1, At, B1); PG8_BAR;
            PG8_LDA(At, 0, 1); PG8_STAGE(PG8_SA(0, 0), a2, voffA);
            PG8_BAR; PG8_WAIT_L(0); PG8_MMA(1, 0, At, B0); PG8_BAR; PG8_SCHED;
            PG8_STAGE(PG8_SB(0, 1), b2 + hstepB, voffB);
            PG8_WAIT_V(6); PG8_BAR; PG8_MMA(1, 1, At, B1); PG8_BAR;
            PG8_LDB(B0, 1, 0); PG8_SCHED; PG8_LDA(At, 1, 0); PG8_STAGE(PG8_SA(0, 1), a2 + hstepA, voffA);
            PG8_WAIT_L(8); PG8_BAR; PG8_WAIT_L(0); PG8_MMA(0, 0, At, B0); PG8_BAR; PG8_SCHED;
            PG8_LDB(B1, 1, 1); PG8_STAGE(PG8_SB(1, 0), b3, voffB);
            PG8_BAR; PG8_WAIT_L(0); PG8_MMA(0, 1, At, B1); PG8_BAR;
            PG8_LDA(At, 1, 1); PG8_STAGE(PG8_SA(1, 0), a3, voffA);
            PG8_BAR; PG8_WAIT_L(0); PG8_MMA(1, 0, At, B0); PG8_BAR; PG8_SCHED;
            PG8_STAGE(PG8_SB(1, 1), b3 + hstepB, voffB);
            PG8_WAIT_V(6); PG8_BAR; PG8_MMA(1, 1, At, B1); PG8_BAR;
            }
        }
        if constexpr (ALIGN_EPI) { if (wr == 0) PG8_BAR; }
        if constexpr (!Epi::AFTER_DRAIN) { E(acc, cur, wr, wc, fr, fq); S.done(cur); }
        if (!has_next) break;
#pragma unroll
        for (int a = 0; a < 2; ++a)
#pragma unroll
            for (int b = 0; b < 2; ++b)
#pragma unroll
                for (int m = 0; m < 4; ++m)
#pragma unroll
                    for (int n = 0; n < 2; ++n) acc[a][b][m][n] = (f32x4){0.f, 0.f, 0.f, 0.f};
        cur = nxt; cA = nA; cB = nB; ++ui;
        if constexpr (ALIGN_EPI) { if (wr == 1) PG8_BAR; }
    }
    PG8_WAIT_V(0);
    if constexpr (!ALIGN_EPI) { if (wr == 0) PG8_BAR; }
    PG8_BAR;
#undef PG8_SA
#undef PG8_SB
#undef PG8_STAGE
#undef PG8_LDA
#undef PG8_LDB
#undef PG8_MMA
#undef PG8_WAIT_V
#undef PG8_WAIT_L
#undef PG8_BAR
#undef PG8_SCHED
}
}

constexpr int NWAVES = 8;
constexpr int BATCH = 8, SEQ = 4096, D = 1024, T = BATCH * SEQ;
constexpr int CONVD = 512, CONVW = 31, SBH = 8, SBD = 64, SBDIM = 512;
constexpr int PH = 8, NKEYS = 128, TOPK = 16, NEXP = NKEYS * NKEYS;
constexpr int NIN = 4096;
constexpr float LN_EPS = 1e-5f;
constexpr float ALPHA = 1.189207115002721f;
constexpr float QSCALE = 0.125f * 1.4426950408889634f;
constexpr int N_PHASES = 12;

constexpr size_t MiB = 1u << 20;
constexpr size_t WS_CTL = 0, CTL_ZERO_BYTES = 1 * MiB;
constexpr size_t WS_WIN = 2 * MiB;
constexpr size_t WS_WV = 10 * MiB;
constexpr size_t WS_WPW2 = 11 * MiB;
constexpr size_t WS_WO = 12 * MiB;
constexpr size_t WS_WOUT = 13 * MiB;
constexpr size_t WS_WEFF = 17 * MiB;
constexpr size_t WS_IDX = 21 * MiB;
constexpr size_t WS_GATE = 37 * MiB;
constexpr size_t WS_UT = 53 * MiB;
constexpr size_t WS_VTAB = 85 * MiB;
constexpr size_t WS_USC = 70 * MiB;
constexpr size_t WS_VSC = 102 * MiB;
constexpr size_t WS_XB = 117 * MiB;
constexpr size_t WS_C = 181 * MiB;
constexpr size_t WS_AO = 213 * MiB;
constexpr size_t WS_GLU = 373 * MiB;
constexpr size_t WS_Q = 405 * MiB;
constexpr size_t WS_K = 437 * MiB;
constexpr size_t WS_VT = 469 * MiB;
constexpr size_t WS_M2 = 373 * MiB;
constexpr size_t WS_G = 245 * MiB;
constexpr size_t WS_R = 245 * MiB;
constexpr size_t WS_ST = 245 * MiB;
constexpr size_t WS_PD = 245 * MiB;
constexpr size_t WS_STATS = 373 * MiB;
constexpr size_t WS_END = 501 * MiB;
constexpr int CW_BAR = 4096;

constexpr int RING_OFF = 0, RING_BYTES = 131072;
constexpr int LDSCTL_OFF = RING_BYTES, MISC_OFF = LDSCTL_OFF + 320;
constexpr int LDS_BYTES = 147456;

#define GAS __attribute__((address_space(1)))
#define LAS __attribute__((address_space(3)))
typedef unsigned short bf16;
typedef unsigned v4u __attribute__((ext_vector_type(4)));
typedef unsigned v2u __attribute__((ext_vector_type(2)));
typedef float f32x4 __attribute__((ext_vector_type(4)));
typedef float f32x16 __attribute__((ext_vector_type(16)));
typedef float f32x2 __attribute__((ext_vector_type(2)));
typedef short bf16x8 __attribute__((ext_vector_type(8)));
typedef GAS unsigned gu32;
#define RLX_AGENT __ATOMIC_RELAXED, __HIP_MEMORY_SCOPE_AGENT
#define LDS_WAIT() asm volatile("s_waitcnt lgkmcnt(0)" ::: "memory")
#define VM_WAIT() asm volatile("s_waitcnt vmcnt(0)" ::: "memory")
__device__ __forceinline__ unsigned f2bf(float f) { unsigned u = __builtin_bit_cast(unsigned, f); return (u + 0x7fffu + ((u >> 16) & 1u)) >> 16; }
__device__ __forceinline__ unsigned pk2(float lo, float hi) { return f2bf(lo) | (f2bf(hi) << 16); }
__device__ __forceinline__ float bflo(unsigned w) { return __uint_as_float(w << 16); }
__device__ __forceinline__ float bfhi(unsigned w) { return __uint_as_float(w & 0xffff0000u); }

#define XB_TMO      128
#define XB_XCNT(j)  (256  + 64 * (j))
#define XB_XSUB(j)  (1280 + 64 * (j))
#define XB_XGEN(j)  (2304 + 64 * (j))
#define XB_TOP      3328
#define XB_TOPGEN   3392
#define XCD_BAR_WORDS 3456
#define XB_SPIN_CAP (1u << 18)
__device__ __forceinline__ unsigned xb_ld(unsigned* p)              { return __hip_atomic_load(p, __ATOMIC_RELAXED, __HIP_MEMORY_SCOPE_AGENT); }
__device__ __forceinline__ unsigned xb_add(unsigned* p, unsigned v) { return __hip_atomic_fetch_add(p, v, __ATOMIC_RELAXED, __HIP_MEMORY_SCOPE_AGENT); }
__device__ __forceinline__ unsigned xb_xcc_id() { return (unsigned)__builtin_amdgcn_s_getreg((3 << 11) | 20) & 0xFu; }
#define XB_SPIN(cond, bar) do { unsigned _sp = 0; while (cond) { __builtin_amdgcn_s_sleep(1); \
    if ((++_sp & 255u) == 0u) { if (xb_ld(&(bar)[XB_TMO])) break; if (_sp > XB_SPIN_CAP) { atomicAdd(&(bar)[XB_TMO], 1u); break; } } } } while (0)
struct XcdBarrier { unsigned* bar; unsigned x; volatile LAS unsigned* st; };
__device__ __forceinline__ XcdBarrier xcd_barrier_post(unsigned* bar, volatile LAS unsigned* st) {
    XcdBarrier b; b.bar = bar; b.x = xb_xcc_id(); b.st = st;
    if (threadIdx.x == 0) (void)xb_add(&bar[XB_XCNT(b.x)], 1u);
    return b;
}
__device__ __forceinline__ void xcd_barrier_complete(unsigned* bar, unsigned x, unsigned& nloc, unsigned& nx) {
    const unsigned G = gridDim.x * gridDim.y * gridDim.z;
    unsigned sum, cnt, mine, sp = 0u;
    for (;;) {
        sum = 0u; cnt = 0u; mine = 0u;
#pragma unroll
        for (unsigned j = 0; j < 16; ++j) { const unsigned c = xb_ld(&bar[XB_XCNT(j)]); sum += c; cnt += (c > 0u) ? 1u : 0u; mine = (j == x) ? c : mine; }
        if (sum == G) break;
        __builtin_amdgcn_s_sleep(1);
        if ((++sp & 255u) == 0u) { if (xb_ld(&bar[XB_TMO])) break; if (sp > XB_SPIN_CAP) { atomicAdd(&bar[XB_TMO], 1u); break; } }
    }
    nloc = mine > 0u ? mine : 1u; nx = cnt > 0u ? cnt : 1u;
}
__device__ __forceinline__ void xcd_barrier(const XcdBarrier& b) {
    asm volatile("s_waitcnt vmcnt(0)" ::: "memory");
    __syncthreads();
    if (threadIdx.x == 0) {
        unsigned* bar = b.bar;
        __builtin_amdgcn_s_waitcnt(0);
        unsigned nloc = b.st[0], nx = b.st[1];
        if (nloc == 0u) { xcd_barrier_complete(bar, b.x, nloc, nx); b.st[0] = nloc; b.st[1] = nx; }
        const unsigned old = xb_add(&bar[XB_XSUB(b.x)], 1u);
        const unsigned gen = old / nloc;
        if (old + 1u == (gen + 1u) * nloc) {
            __builtin_amdgcn_fence(__ATOMIC_RELEASE, "agent");
            asm volatile("s_waitcnt vmcnt(0)" ::: "memory");
            const unsigned og = xb_add(&bar[XB_TOP], 1u);
            const unsigned tg = og / nx;
            if (og + 1u == (tg + 1u) * nx) xb_add(&bar[XB_TOPGEN], 1u);
            else XB_SPIN(xb_ld(&bar[XB_TOPGEN]) == tg, bar);
            __builtin_amdgcn_fence(__ATOMIC_ACQUIRE, "agent");
            xb_add(&bar[XB_XGEN(b.x)], 1u);
            asm volatile("s_waitcnt vmcnt(0)" ::: "memory");
        } else {
            XB_SPIN(xb_ld(&bar[XB_XGEN(b.x)]) == gen, bar);
            __builtin_amdgcn_fence(__ATOMIC_ACQUIRE, "agent");
            asm volatile("s_waitcnt vmcnt(0)" ::: "memory");
        }
    }
    __syncthreads();
}

struct Frame {
    LAS unsigned char* lds;
    volatile LAS unsigned* MISC;
    gu32* ctl;
    int tid, lane, wave;
    int vcu, G;
    const float *x, *w_in, *b_in, *cw_dw, *cb_dw, *cln_g, *cln_b, *w_pw2, *b_pw2, *w_o, *w_out, *b_out, *ln1_g, *ln1_b, *w_q, *keys1, *keys2, *pu, *pv, *ln2_g, *ln2_b;
    float* out;
    unsigned char *UT, *VTAB; float *USC, *VSC;
    bf16 *WinT, *WvT, *Wpw2T, *WoT, *WoutT, *WeffT, *XB, *Cb, *AO, *GLU, *Qb, *Kb, *VT, *M2, *Gt;
    float *R, *ST, *GATE, *PD, *STATS; int* IDX;
};

__device__ __forceinline__ float wave_sum(float v) {
#pragma unroll
    for (int o = 1; o < 64; o <<= 1) v += __shfl_xor(v, o);
    return v;
}

__device__ __forceinline__ void p0_transpose_item(const float* W, int ldw, int src_col0, int k0, bf16* WT, int ldt, int dst_row0, int dst_k0, LAS float* scr, int lane) {
#pragma unroll 8
    for (int i = 0; i < 32; ++i) { const int kk = 2 * i + (lane >> 5); scr[kk * 33 + (lane & 31)] = W[(size_t)(k0 + kk) * ldw + src_col0 + (lane & 31)]; }
    LDS_WAIT(); asm volatile("" ::: "memory");
    const int c = lane & 7;
#pragma unroll
    for (int j = 0; j < 4; ++j) { const int n = (lane >> 3) + 8 * j; const LAS float* s = scr + (8 * c) * 33 + n;
        v4u o; o.x = pk2(s[0 * 33], s[1 * 33]); o.y = pk2(s[2 * 33], s[3 * 33]); o.z = pk2(s[4 * 33], s[5 * 33]); o.w = pk2(s[6 * 33], s[7 * 33]);
        *(GAS v4u*)(WT + (size_t)(dst_row0 + n) * ldt + dst_k0 + 8 * c) = o; }
    LDS_WAIT(); asm volatile("" ::: "memory");
}
__device__ __forceinline__ void p0_convert(const float* src, bf16* dst, size_t n8, int gw, int NGW, int lane) {
    for (size_t i = (size_t)gw * 64 + lane; i < n8; i += (size_t)NGW * 64) {
        const f32x4 a = *(const GAS f32x4*)(src + i * 8), b = *(const GAS f32x4*)(src + i * 8 + 4);
        v4u o; o.x = pk2(a.x, a.y); o.y = pk2(a.z, a.w); o.z = pk2(b.x, b.y); o.w = pk2(b.z, b.w);
        *(GAS v4u*)(dst + i * 8) = o; }
}
__device__ __forceinline__ float wave_max(float v) {
#pragma unroll
    for (int o = 1; o < 64; o <<= 1) v = fmaxf(v, __shfl_xor(v, o));
    return v;
}
__device__ __forceinline__ void p0_row_fp8(const float* src, unsigned char* dst, float* inv_scale, int lane) {
    f32x4 v[4]; float m = 0.f;
#pragma unroll
    for (int j = 0; j < 4; ++j) { v[j] = *(const GAS f32x4*)(src + 16 * lane + 4 * j); m = fmaxf(m, fmaxf(fmaxf(fabsf(v[j].x), fabsf(v[j].y)), fmaxf(fabsf(v[j].z), fabsf(v[j].w)))); }
    m = wave_max(m);
    const float sc = m > 0.f ? 256.0f / m : 1.0f;
    v4u o; unsigned w;
    w = 0u; w = __builtin_amdgcn_cvt_pk_fp8_f32(v[0].x * sc, v[0].y * sc, w, false); w = __builtin_amdgcn_cvt_pk_fp8_f32(v[0].z * sc, v[0].w * sc, w, true); o.x = w;
    w = 0u; w = __builtin_amdgcn_cvt_pk_fp8_f32(v[1].x * sc, v[1].y * sc, w, false); w = __builtin_amdgcn_cvt_pk_fp8_f32(v[1].z * sc, v[1].w * sc, w, true); o.y = w;
    w = 0u; w = __builtin_amdgcn_cvt_pk_fp8_f32(v[2].x * sc, v[2].y * sc, w, false); w = __builtin_amdgcn_cvt_pk_fp8_f32(v[2].z * sc, v[2].w * sc, w, true); o.z = w;
    w = 0u; w = __builtin_amdgcn_cvt_pk_fp8_f32(v[3].x * sc, v[3].y * sc, w, false); w = __builtin_amdgcn_cvt_pk_fp8_f32(v[3].z * sc, v[3].w * sc, w, true); o.w = w;
    *(GAS v4u*)(dst + ((size_t)(lane >> 3) << 21) + 16 * (lane & 7)) = o;
    if (lane == 0) *inv_scale = m > 0.f ? m * (1.0f / 256.0f) : 1.0f;
}
__device__ __forceinline__ void p0_weff_tile(Frame& F, int tile) {
    const int lane = F.lane, r32 = lane & 31, hi = lane >> 5;
    const int it = tile & 31, kt = (tile >> 5) & 3, g = tile >> 7;
    const int h = g >> 1, half = g & 1;
    const float* kp = (half ? F.keys2 : F.keys1) + ((size_t)h * NKEYS + kt * 32 + r32) * 128 + 64 * hi;
    const float* wp = F.w_q + (size_t)(it * 32 + r32) * 2048 + g * 128 + 64 * hi;
    f32x4 a[16], b[16];
#pragma unroll
    for (int j = 0; j < 16; ++j) { a[j] = *(const GAS f32x4*)(kp + 4 * j); b[j] = *(const GAS f32x4*)(wp + 4 * j); }
    f32x16 c = {};
#pragma unroll
    for (int j = 0; j < 16; ++j)
#pragma unroll
        for (int e = 0; e < 4; ++e) c = __builtin_amdgcn_mfma_f32_32x32x2f32(a[j][e], b[j][e], c, 0, 0, 0);
#pragma unroll
    for (int r = 0; r < 16; ++r) { const int row = (r & 3) + 8 * (r >> 2) + 4 * hi;
        F.WeffT[(size_t)(g * 128 + kt * 32 + row) * 1024 + it * 32 + r32] = (bf16)f2bf(c[r]); }
}
__device__ __forceinline__ void p0_prologue(Frame& F) {
    LAS float* scr = (LAS float*)(F.lds + RING_OFF + F.wave * 16384);
    const int gw = F.vcu * NWAVES + F.wave, NGW = F.G * NWAVES;
    constexpr int I_IN = 16 * 128, I_V = 16 * 16, I_P = 8 * 32, I_O = 8 * 32, I_W = 16 * 32;
    constexpr int NITEMS = I_IN + I_V + I_P + I_O + I_W;
    for (int itx = gw; itx < NITEMS; itx += NGW) {
        int r = itx;
        if (r < I_IN) { const int kb = r / 128, nb = r % 128, j0 = nb * 32;
            int oc; if (j0 < 1024) { const int pn = j0 >> 8, w = j0 & 255; oc = (w < 128) ? pn * 128 + w : 512 + pn * 128 + (w - 128); } else if (j0 < 2048) oc = j0; else oc = j0 + 512;
            p0_transpose_item(F.w_in, 4608, oc, kb * 64, F.WinT, 1024, j0, kb * 64, scr, F.lane); continue; } r -= I_IN;
        if (r < I_V) { const int kb = r / 16, nb = r % 16; p0_transpose_item(F.w_in, 4608, 2048 + nb * 32, kb * 64, F.WvT, 1024, nb * 32, kb * 64, scr, F.lane); continue; } r -= I_V;
        if (r < I_P) { const int kb = r / 32, nb = r % 32; p0_transpose_item(F.w_pw2, 1024, nb * 32, kb * 64, F.Wpw2T, 512, nb * 32, kb * 64, scr, F.lane); continue; } r -= I_P;
        if (r < I_O) { const int kb = r / 32, nb = r % 32; p0_transpose_item(F.w_o, 1024, nb * 32, kb * 64, F.WoT, 512, nb * 32, kb * 64, scr, F.lane); continue; } r -= I_O;
        { const int kb = r / 32, nb = r % 32; p0_transpose_item(F.w_out, 1024, nb * 32, kb * 64, F.WoutT, 1024, nb * 32, kb * 64, scr, F.lane); }
    }
    for (int tile = gw; tile < 2048; tile += NGW) p0_weff_tile(F, tile);
    p0_convert(F.x, F.XB, (size_t)T * D / 8, gw, NGW, F.lane);
    for (int r = gw; r < 2 * NEXP; r += NGW) { if (r < NEXP) p0_row_fp8(F.pu + (size_t)r * D, F.UT + (size_t)r * 128, F.USC + r, F.lane); else p0_row_fp8(F.pv + (size_t)(r - NEXP) * D, F.VTAB + (size_t)(r - NEXP) * 128, F.VSC + (r - NEXP), F.lane); }
}

__device__ __forceinline__ void conv_unit(Frame& F, int ct) {
    const int tid = F.tid, lane = F.lane, w = F.wave;
    const int tb = ct * 64, p0 = tb & (SEQ - 1);
    LAS unsigned char* L = F.lds + RING_OFF;
    for (int c = tid; c < 94 * 64; c += NWAVES * 64) { const int r = c >> 6, ch = c & 63; v4u v = (v4u){0u, 0u, 0u, 0u};
        if (p0 - 30 + r >= 0) v = *(const GAS v4u*)(F.GLU + (size_t)(tb - 30 + r) * CONVD + ch * 8);
        *(LAS v4u*)(L + r * 1024 + ch * 16) = v; }
    __syncthreads();
    float s1[8], s2[8];
#pragma unroll
    for (int i = 0; i < 8; ++i) { s1[i] = 0.f; s2[i] = 0.f; }
#define CONV_BODY() \
        const int p = lane + 64 * q, c0 = 2 * p; \
        const f32x2 bb = *(const GAS f32x2*)(F.cb_dw + c0); \
        float a0[8], a1[8]; \
        _Pragma("unroll") for (int i = 0; i < 8; ++i) { a0[i] = bb.x; a1[i] = bb.y; } \
        float w0[CONVW], w1[CONVW]; \
        _Pragma("unroll") for (int rr = 0; rr < 38; ++rr) { \
            if (rr < CONVW) { const f32x2 ww = *(const GAS f32x2*)(F.cw_dw + rr * CONVD + c0); w0[rr] = ww.x; w1[rr] = ww.y; } \
            const unsigned g2 = *(const LAS unsigned*)(L + (8 * w + rr) * 1024 + p * 4); \
            const float lo = bflo(g2), hi = bfhi(g2); \
            _Pragma("unroll") for (int i = 0; i < 8; ++i) { const int j = rr - i; if (j >= 0 && j < CONVW) { a0[i] += w0[j] * lo; a1[i] += w1[j] * hi; } } \
        }
#pragma unroll 1
    for (int q = 0; q < 4; ++q) {
        CONV_BODY()
#pragma unroll
        for (int i = 0; i < 8; ++i) { s1[i] += a0[i] + a1[i]; s2[i] += a0[i] * a0[i] + a1[i] * a1[i]; }
    }
    float mean[8], rstd[8];
#pragma unroll
    for (int i = 0; i < 8; ++i) { mean[i] = wave_sum(s1[i]) * (1.0f / CONVD); const float var = wave_sum(s2[i]) * (1.0f / CONVD) - mean[i] * mean[i];
        rstd[i] = 1.0f / sqrtf(fmaxf(var, 0.f) + LN_EPS); }
#pragma unroll 1
    for (int q = 0; q < 4; ++q) {
        CONV_BODY()
        const f32x2 gg = *(const GAS f32x2*)(F.cln_g + c0), lb = *(const GAS f32x2*)(F.cln_b + c0);
#pragma unroll
        for (int i = 0; i < 8; ++i) { float v0 = (a0[i] - mean[i]) * rstd[i] * gg.x + lb.x, v1 = (a1[i] - mean[i]) * rstd[i] * gg.y + lb.y;
            v0 = v0 * pg8::sigmoid_f(v0); v1 = v1 * pg8::sigmoid_f(v1);
            *(GAS unsigned*)(F.Cb + (size_t)(tb + 8 * w + i) * CONVD + c0) = pk2(v0, v1); }
    }
#undef CONV_BODY
    __syncthreads();
}

__device__ __forceinline__ unsigned cvtpk_s(float lo, float hi) { typedef float f2 __attribute__((ext_vector_type(2))); typedef __bf16 b2 __attribute__((ext_vector_type(2))); f2 v = {lo, hi}; b2 b = __builtin_convertvector(v, b2); return __builtin_bit_cast(unsigned, b); }
__device__ __forceinline__ void attn_task(Frame& F, int task) {
    const int lane = F.lane, r32 = lane & 31, hi = lane >> 5;
    const int qblk = task & 127, h = (task >> 7) & 7, b = task >> 10;
    const int q0 = qblk * 32; const size_t rowbase = (size_t)b * SEQ;
    bf16x8 qf[4];
#pragma unroll
    for (int d0 = 0; d0 < 4; ++d0) qf[d0] = *(const GAS bf16x8*)(F.Qb + (rowbase + q0 + r32) * SBDIM + h * SBD + d0 * 16 + hi * 8);
    f32x16 o0 = {}, o1 = {};
    float Rc = 1.0f;
    const int kperm = 32 * ((r32 >> 2) & 1) + 4 * (r32 >> 3) + (r32 & 3);
    const int jt0 = q0 >> 6;
    const int qpos = q0 + r32;
    for (int jt = jt0; jt >= 0; --jt) {
        const int t0 = jt * 64;
        bf16x8 kf[2][4];
#pragma unroll
        for (int p = 0; p < 2; ++p)
#pragma unroll
            for (int d0 = 0; d0 < 4; ++d0) kf[p][d0] = *(const GAS bf16x8*)(F.Kb + (rowbase + t0 + kperm + 16 * p) * SBDIM + h * SBD + d0 * 16 + hi * 8);
        bf16x8 vf[2][2][2];
#pragma unroll
        for (int dt = 0; dt < 2; ++dt)
#pragma unroll
            for (int p = 0; p < 2; ++p)
#pragma unroll
                for (int s = 0; s < 2; ++s) vf[dt][p][s] = *(const GAS bf16x8*)(F.VT + (size_t)(h * SBD + dt * 32 + r32) * T + rowbase + t0 + 32 * hi + 16 * p + 8 * s);
        f32x16 sp[2];
#pragma unroll
        for (int p = 0; p < 2; ++p) { sp[p] = (f32x16){};
#pragma unroll
            for (int d0 = 0; d0 < 4; ++d0) sp[p] = __builtin_amdgcn_mfma_f32_32x32x16_bf16(kf[p][d0], qf[d0], sp[p], 0, 0, 0); }
        float rr[32], be[32];
#pragma unroll
        for (int p = 0; p < 2; ++p)
#pragma unroll
            for (int r = 0; r < 16; ++r) { const float e = __builtin_amdgcn_exp2f(sp[p][r]); const float om = __builtin_amdgcn_rcpf(1.0f + e); rr[16 * p + r] = om; be[16 * p + r] = 1.0f - om; }
        if (jt == jt0) {
#pragma unroll
            for (int i = 0; i < 32; ++i) { const bool valid = (t0 + 32 * hi + i) < qpos; rr[i] = valid ? rr[i] : 1.0f; be[i] = valid ? be[i] : 0.0f; }
        }
        float tt[16];
#pragma unroll
        for (int i = 0; i < 16; ++i) tt[i] = rr[2 * i] * rr[2 * i + 1];
#pragma unroll
        for (int i = 0; i < 8; ++i) tt[i] = tt[2 * i] * tt[2 * i + 1];
#pragma unroll
        for (int i = 0; i < 4; ++i) tt[i] = tt[2 * i] * tt[2 * i + 1];
        const float tot = (tt[0] * tt[1]) * (tt[2] * tt[3]);
        const float oth = __shfl_xor(tot, 32);
        float run = hi ? Rc : Rc * oth;
        Rc = Rc * tot * oth;
        float pa[32];
#pragma unroll
        for (int i = 31; i >= 0; --i) { pa[i] = be[i] * run; run *= rr[i]; }
#pragma unroll
        for (int p = 0; p < 2; ++p)
#pragma unroll
            for (int s = 0; s < 2; ++s) { v4u pw; const int bs = 16 * p + 8 * s;
                pw.x = cvtpk_s(pa[bs], pa[bs + 1]); pw.y = cvtpk_s(pa[bs + 2], pa[bs + 3]); pw.z = cvtpk_s(pa[bs + 4], pa[bs + 5]); pw.w = cvtpk_s(pa[bs + 6], pa[bs + 7]);
                const bf16x8 pf = __builtin_bit_cast(bf16x8, pw);
                o0 = __builtin_amdgcn_mfma_f32_32x32x16_bf16(pf, vf[0][p][s], o0, 0, 0, 0);
                o1 = __builtin_amdgcn_mfma_f32_32x32x16_bf16(pf, vf[1][p][s], o1, 0, 0, 0); }
        if (__all(Rc < 1e-12f)) break;
    }
#pragma unroll
    for (int r = 0; r < 16; ++r) { const int q = (r & 3) + 8 * (r >> 2) + 4 * hi; bf16* op = F.AO + (rowbase + q0 + q) * SBDIM + h * SBD + r32;
        op[0] = (bf16)f2bf(o0[r]); op[32] = (bf16)f2bf(o1[r]); }
}

__device__ __forceinline__ void ln1_row(Frame& F, int m) {
    const GAS f32x4* xr = (const GAS f32x4*)(F.R + (size_t)m * D) + F.lane;
    f32x4 v[4]; float s = 0.f;
#pragma unroll
    for (int j = 0; j < 4; ++j) { v[j] = xr[64 * j]; s += (v[j].x + v[j].y) + (v[j].z + v[j].w); }
    const float mean = wave_sum(s) * (1.f / D); float s2 = 0.f;
#pragma unroll
    for (int j = 0; j < 4; ++j) { v[j] = v[j] - mean; s2 += (v[j].x * v[j].x + v[j].y * v[j].y) + (v[j].z * v[j].z + v[j].w * v[j].w); }
    const float rstd = 1.f / sqrtf(wave_sum(s2) * (1.f / D) + LN_EPS);
    GAS v2u* o8 = (GAS v2u*)(F.XB + (size_t)m * D) + F.lane;
#pragma unroll
    for (int j = 0; j < 4; ++j) { const f32x4 gg = *((const GAS f32x4*)F.ln1_g + F.lane + 64 * j), bb = *((const GAS f32x4*)F.ln1_b + F.lane + 64 * j);
        const f32x4 y = v[j] * rstd * gg + bb; v2u o; o.x = pk2(y.x, y.y); o.y = pk2(y.z, y.w); o8[64 * j] = o; }
}

#define CE_DESC(a, b) do { const unsigned _x = (a), _y = (b); (a) = _x > _y ? _x : _y; (b) = _x > _y ? _y : _x; } while (0)
__device__ __forceinline__ unsigned f2key(float f) { const unsigned u = __float_as_uint(f); return (u & 0x80000000u) ? ~u : (u | 0x80000000u); }
__device__ __forceinline__ float key2f(unsigned k) { const unsigned u = (k & 0x80000000u) ? (k & 0x7fffffffu) : ~k; return __uint_as_float(u); }
__device__ __forceinline__ void sort16_desc(unsigned (&a)[16]) {
#pragma unroll
    for (int k = 2; k <= 16; k <<= 1)
#pragma unroll
        for (int j = k >> 1; j > 0; j >>= 1)
#pragma unroll
            for (int i = 0; i < 16; ++i) { const int l = i ^ j; if (l > i) { if ((i & k) == 0) CE_DESC(a[i], a[l]); else CE_DESC(a[l], a[i]); } }
}
__device__ __forceinline__ void merge16_desc(unsigned (&t)[16], const unsigned (&c)[16]) {
#pragma unroll
    for (int i = 0; i < 16; ++i) t[i] = t[i] > c[15 - i] ? t[i] : c[15 - i];
#pragma unroll
    for (int j = 8; j > 0; j >>= 1)
#pragma unroll
        for (int i = 0; i < 16; ++i) { const int l = i ^ j; if (l > i) CE_DESC(t[i], t[l]); }
}
__device__ __forceinline__ void top16_of_128(const _Float16* col, unsigned (&top)[16]) {
#pragma unroll 1
    for (int c = 0; c < 8; ++c) {
        unsigned a[16];
#pragma unroll
        for (int i = 0; i < 16; ++i) { const float v = (float)*(const GAS _Float16*)(col + (size_t)(c * 16 + i) * T); a[i] = (f2key(v) & ~127u) | (unsigned)(127 - (c * 16 + i)); }
        sort16_desc(a);
        if (c == 0) {
#pragma unroll
            for (int i = 0; i < 16; ++i) top[i] = a[i];
        } else merge16_desc(top, a);
    }
}
__device__ __forceinline__ void select_task(Frame& F, int task) {
    const int lane = F.lane, w = F.wave;
    const int h = task & 7, tblk = task >> 3; const int t = tblk * 64 + lane;
    unsigned v1[16], v2[16];
    top16_of_128((const _Float16*)F.ST + (size_t)(h * 256) * T + t, v1);
    top16_of_128((const _Float16*)F.ST + (size_t)(h * 256 + 128) * T + t, v2);
    LAS unsigned* L = (LAS unsigned*)(F.lds + RING_OFF) + w * 2048;
#pragma unroll
    for (int i = 0; i < 16; ++i) { L[i * 64 + lane] = v1[i]; L[(16 + i) * 64 + lane] = v2[i]; }
    float f1[16], f2[16];
#pragma unroll
    for (int i = 0; i < 16; ++i) { f1[i] = key2f(v1[i] & ~127u); f2[i] = key2f(v2[i] & ~127u); }
    unsigned top[16], cg[16];
#define CAND(i, j) ((f2key(f1[i] + f2[j]) & ~255u) | (unsigned)((i) * 16 + (j)))
#pragma unroll
    for (int j = 0; j < 16; ++j) top[j] = CAND(0, j);
    sort16_desc(top);
#pragma unroll
    for (int j = 0; j < 8; ++j) { cg[j] = CAND(1, j); cg[8 + j] = CAND(8 + j, 0); }
    sort16_desc(cg); merge16_desc(top, cg);
    cg[0] = CAND(2, 0); cg[1] = CAND(2, 1); cg[2] = CAND(2, 2); cg[3] = CAND(2, 3); cg[4] = CAND(2, 4);
    cg[5] = CAND(3, 0); cg[6] = CAND(3, 1); cg[7] = CAND(3, 2); cg[8] = CAND(3, 3);
    cg[9] = CAND(4, 0); cg[10] = CAND(4, 1); cg[11] = CAND(4, 2);
    cg[12] = CAND(5, 0); cg[13] = CAND(5, 1); cg[14] = CAND(6, 0); cg[15] = CAND(6, 1);
    sort16_desc(cg); merge16_desc(top, cg);
    cg[0] = CAND(7, 0); cg[1] = CAND(7, 1);
#pragma unroll
    for (int j = 2; j < 16; ++j) cg[j] = 0u;
    sort16_desc(cg); merge16_desc(top, cg);
#undef CAND
    LDS_WAIT(); asm volatile("" ::: "memory");
    float sv[16]; int ex[16];
#pragma unroll
    for (int j = 0; j < 16; ++j) { const unsigned k = top[j]; const int ci = (k >> 4) & 15, cj = k & 15;
        sv[j] = key2f(k & ~255u);
        const unsigned a = L[ci * 64 + lane], bq = L[(16 + cj) * 64 + lane];
        ex[j] = (127 - (int)(a & 127u)) * NKEYS + (127 - (int)(bq & 127u)); }
    float mx = sv[0], sum = 0.f;
#pragma unroll
    for (int j = 0; j < 16; ++j) { sv[j] = __builtin_amdgcn_exp2f((sv[j] - mx) * 1.4426950408889634f); sum += sv[j]; }
    const float inv = 1.0f / sum;
    GAS v4u* ip = (GAS v4u*)(F.IDX + (size_t)t * 128 + h * 16); GAS f32x4* gp = (GAS f32x4*)(F.GATE + (size_t)t * 128 + h * 16);
#pragma unroll
    for (int j = 0; j < 4; ++j) { ip[j] = (v4u){(unsigned)ex[4 * j], (unsigned)ex[4 * j + 1], (unsigned)ex[4 * j + 2], (unsigned)ex[4 * j + 3]};
        gp[j] = (f32x4){sv[4 * j] * inv, sv[4 * j + 1] * inv, sv[4 * j + 2] * inv, sv[4 * j + 3] * inv}; }
    LDS_WAIT(); asm volatile("" ::: "memory");
}

__device__ __forceinline__ float dot2bf(unsigned a, unsigned b, float acc) {
    typedef __bf16 b2 __attribute__((ext_vector_type(2)));
    return __builtin_amdgcn_fdot2_f32_bf16(__builtin_bit_cast(b2, a), __builtin_bit_cast(b2, b), acc, false);
}
__device__ __forceinline__ float gelu_erf(float v) {
    const float av = fabsf(v), t = __builtin_amdgcn_rcpf(av * 0.2316418882f + 1.0f);
    float q = t * 0.5307027145f + (-0.7265760135f); q = q * t + 0.7107068705f; q = q * t + (-0.142248368f); q = q * t + 0.127414796f; q = q * t;
    const float e = __builtin_amdgcn_exp2f((v * v) * (-0.72134752044f));
    const float m = v * (q * e);
    return v < 0.f ? m : v - m;
}
#define DPPF(v, ctrl) __builtin_bit_cast(float, __builtin_amdgcn_update_dpp(0, __builtin_bit_cast(int, (v)), (ctrl), 0xF, 0xF, true))
__device__ __forceinline__ float row16_sum(float v) {
    v += DPPF(v, 0xB1); v += DPPF(v, 0x4E); v += DPPF(v, 0x141); v += DPPF(v, 0x140); return v;
}
__device__ __forceinline__ float xgroup_sum(float v) {
    { auto r = __builtin_amdgcn_permlane16_swap(__float_as_uint(v), __float_as_uint(v), false, false); v = __uint_as_float(r[0]) + __uint_as_float(r[1]); }
    { auto r = __builtin_amdgcn_permlane32_swap(__float_as_uint(v), __float_as_uint(v), false, false); v = __uint_as_float(r[0]) + __uint_as_float(r[1]); }
    return v;
}
__device__ __forceinline__ float row8_sum(float v) {
    v += DPPF(v, 0xB1); v += DPPF(v, 0x4E); v += DPPF(v, 0x141); return v;
}
__device__ __forceinline__ float col8_sum(float v) {
    v += DPPF(v, 0x128);
    { auto r = __builtin_amdgcn_permlane16_swap(__float_as_uint(v), __float_as_uint(v), false, false); v = __uint_as_float(r[0]) + __uint_as_float(r[1]); }
    { auto r = __builtin_amdgcn_permlane32_swap(__float_as_uint(v), __float_as_uint(v), false, false); v = __uint_as_float(r[0]) + __uint_as_float(r[1]); }
    return v;
}
template <bool VPH>
__device__ __forceinline__ void peer_slice_phase(Frame& F) {
    const int lane = F.lane, r8 = lane >> 3, c8 = lane & 7;
    const int sl = (int)blockIdx.x & 7, rank = (int)blockIdx.x >> 3, nr = F.G >> 3;
    LAS int* Lidx = (LAS int*)(F.lds + RING_OFF + F.wave * 8192);
    LAS float* Lco = (LAS float*)(Lidx + 512);
    const unsigned char* tab = (VPH ? F.VTAB : F.UT) + ((size_t)sl << 21);
    const unsigned c8o = (unsigned)c8 * 16u;
    const int tstride = nr * 8, t0 = rank * 8 + F.wave;
    const int NT = (t0 < T) ? (T - t0 + tstride - 1) / tstride : 0;
    if (NT == 0) return;
    v4u b0[8], b1[8], b2[8], b3[8]; v4u xE[2], xO[2] = {}; int i0 = 0, i1 = 0; float g0 = 0.f, g1 = 0.f;
    float acc[16];
#define TOK(n) (t0 + ((n) < NT ? (n) : NT - 1) * tstride)
#define S_LOAD_IDX(n) do { const size_t o_ = (size_t)TOK(n) * 128; i0 = F.IDX[o_ + lane]; i1 = F.IDX[o_ + 64 + lane]; if (VPH) { g0 = F.GATE[o_ + lane]; g1 = F.GATE[o_ + 64 + lane]; } } while (0)
#define S_PUT_IDX(n) do { const int sl_ = ((n) & 3) * 128; Lidx[sl_ + lane] = i0; Lidx[sl_ + 64 + lane] = i1; if (VPH) { Lco[sl_ + lane] = g0; Lco[sl_ + 64 + lane] = g1; } LDS_WAIT(); asm volatile("" ::: "memory"); } while (0)
#define S_ISSUE(buf, n, h) do { \
        _Pragma("unroll") for (int it = 0; it < 8; ++it) { const int e_ = Lidx[((n) & 3) * 128 + (h) * 64 + it * 8 + r8]; buf[it] = *(const GAS v4u*)(tab + (size_t)(((unsigned)e_ << 7) + c8o)); } } while (0)
#define S_LOAD_X(xb, n) do { const GAS v4u* xp_ = (const GAS v4u*)(F.XB + (size_t)TOK(n) * D + sl * 128 + c8 * 16); xb[0] = xp_[0]; xb[1] = xp_[1]; } while (0)
#define S_CVT16(W_, f) do { const f32x2 q0_ = __builtin_amdgcn_cvt_pk_f32_fp8((W_).x, false), q1_ = __builtin_amdgcn_cvt_pk_f32_fp8((W_).x, true), q2_ = __builtin_amdgcn_cvt_pk_f32_fp8((W_).y, false), q3_ = __builtin_amdgcn_cvt_pk_f32_fp8((W_).y, true); \
        const f32x2 q4_ = __builtin_amdgcn_cvt_pk_f32_fp8((W_).z, false), q5_ = __builtin_amdgcn_cvt_pk_f32_fp8((W_).z, true), q6_ = __builtin_amdgcn_cvt_pk_f32_fp8((W_).w, false), q7_ = __builtin_amdgcn_cvt_pk_f32_fp8((W_).w, true); \
        f[0] = q0_.x; f[1] = q0_.y; f[2] = q1_.x; f[3] = q1_.y; f[4] = q2_.x; f[5] = q2_.y; f[6] = q3_.x; f[7] = q3_.y; f[8] = q4_.x; f[9] = q4_.y; f[10] = q5_.x; f[11] = q5_.y; f[12] = q6_.x; f[13] = q6_.y; f[14] = q7_.x; f[15] = q7_.y; } while (0)
#define S_XF(xb, xf) do { xf[0] = bflo(xb[0].x); xf[1] = bfhi(xb[0].x); xf[2] = bflo(xb[0].y); xf[3] = bfhi(xb[0].y); xf[4] = bflo(xb[0].z); xf[5] = bfhi(xb[0].z); xf[6] = bflo(xb[0].w); xf[7] = bfhi(xb[0].w); \
        xf[8] = bflo(xb[1].x); xf[9] = bfhi(xb[1].x); xf[10] = bflo(xb[1].y); xf[11] = bfhi(xb[1].y); xf[12] = bflo(xb[1].z); xf[13] = bfhi(xb[1].z); xf[14] = bflo(xb[1].w); xf[15] = bfhi(xb[1].w); } while (0)
#define S_COMPUTE(buf, xb, n, h) do { { float xf[16]; if (!VPH || (h)) S_XF(xb, xf); \
        if (!VPH) { \
            _Pragma("unroll") for (int it = 0; it < 8; ++it) { float f[16]; S_CVT16(buf[it], f); float da_ = 0.f, db_ = 0.f; \
                _Pragma("unroll") for (int k = 0; k < 16; k += 2) { da_ += f[k] * xf[k]; db_ += f[k + 1] * xf[k + 1]; } \
                const float d_ = row8_sum(da_ + db_); if (c8 == 0) Lco[(h) * 64 + it * 8 + r8] = d_; } \
            if (h) { LDS_WAIT(); asm volatile("" ::: "memory"); \
                const float d0_ = Lco[lane], d1_ = Lco[lane + 64]; \
                GAS float* pd_ = (GAS float*)(F.PD + ((size_t)TOK(n) * 8 + sl) * 128); pd_[lane] = d0_; pd_[lane + 64] = d1_; \
                LDS_WAIT(); asm volatile("" ::: "memory"); } \
        } else { \
            if (!(h)) { _Pragma("unroll") for (int k = 0; k < 16; ++k) acc[k] = 0.f; } \
            _Pragma("unroll") for (int it = 0; it < 8; ++it) { float f[16]; S_CVT16(buf[it], f); const float cf_ = Lco[((n) & 3) * 128 + (h) * 64 + it * 8 + r8]; \
                _Pragma("unroll") for (int k = 0; k < 16; ++k) acc[k] += cf_ * f[k]; __builtin_amdgcn_sched_barrier(0); } \
            if (h) { float s1_ = 0.f, s2_ = 0.f; \
                _Pragma("unroll") for (int k = 0; k < 16; ++k) { acc[k] = col8_sum(acc[k]) + ALPHA * xf[k]; s1_ += acc[k]; s2_ += acc[k] * acc[k]; } \
                s1_ = row8_sum(s1_); s2_ = row8_sum(s2_); \
                { f32x4 o_; \
                  o_.x = r8 == 0 ? acc[0] : r8 == 1 ? acc[4] : r8 == 2 ? acc[8] : acc[12]; o_.y = r8 == 0 ? acc[1] : r8 == 1 ? acc[5] : r8 == 2 ? acc[9] : acc[13]; \
                  o_.z = r8 == 0 ? acc[2] : r8 == 1 ? acc[6] : r8 == 2 ? acc[10] : acc[14]; o_.w = r8 == 0 ? acc[3] : r8 == 1 ? acc[7] : r8 == 2 ? acc[11] : acc[15]; \
                  if (r8 < 4) *(GAS f32x4*)(F.out + (size_t)TOK(n) * D + sl * 128 + c8 * 16 + r8 * 4) = o_; } \
                if (lane == 0) { GAS float* st_ = (GAS float*)(F.STATS + ((size_t)TOK(n) * 8 + sl) * 2); st_[0] = s1_; st_[1] = s2_; } } \
        } } } while (0)
    S_LOAD_IDX(0); S_PUT_IDX(0); S_LOAD_IDX(1); S_PUT_IDX(1);
    S_ISSUE(b0, 0, 0); S_ISSUE(b1, 0, 1); S_ISSUE(b2, 1, 0); S_LOAD_X(xE, 0);
    S_LOAD_IDX(2);
#pragma unroll 1
    for (int n = 0; n < NT; n += 2) {
        S_ISSUE(b3, n + 1, 1);
        S_COMPUTE(b0, xE, n, 0);
        S_PUT_IDX(n + 2); S_LOAD_IDX(n + 3); S_ISSUE(b0, n + 2, 0); if (!VPH) S_LOAD_X(xO, n + 1);
        S_COMPUTE(b1, xE, n, 1);
        if (VPH) S_LOAD_X(xE, n + 1);
        S_ISSUE(b1, n + 2, 1);
        if (VPH) S_COMPUTE(b2, xE, n + 1, 0); else S_COMPUTE(b2, xO, n + 1, 0);
        S_PUT_IDX(n + 3); S_LOAD_IDX(n + 4); S_ISSUE(b2, n + 3, 0); if (!VPH) S_LOAD_X(xE, n + 2);
        if (VPH) S_COMPUTE(b3, xE, n + 1, 1); else S_COMPUTE(b3, xO, n + 1, 1);
        if (VPH) S_LOAD_X(xE, n + 2);
    }
#undef TOK
#undef S_LOAD_IDX
#undef S_PUT_IDX
#undef S_ISSUE
#undef S_LOAD_X
#undef S_CVT16
#undef S_XF
#undef S_COMPUTE
}
__device__ __forceinline__ void peer_coef_phase(Frame& F) {
    const size_t total = (size_t)T * 128, stride = (size_t)F.G * NWAVES * 64;
    for (size_t q = ((size_t)F.vcu * NWAVES + F.wave) * 64 + F.lane; q < total; q += stride) {
        const size_t t = q >> 7; const int j = (int)(q & 127);
        const GAS float* pd = (const GAS float*)(F.PD + t * 1024 + j);
        float d = 0.f;
#pragma unroll
        for (int sl = 0; sl < 8; ++sl) d += pd[sl * 128];
        const int e = F.IDX[q];
        F.GATE[q] = F.GATE[q] * gelu_erf(d * F.USC[e]) * F.VSC[e];
    }
}
__device__ __forceinline__ void ln2_row(Frame& F, int m) {
    GAS f32x4* zr = (GAS f32x4*)(F.out + (size_t)m * D) + F.lane;
    f32x4 v[4];
#pragma unroll
    for (int j = 0; j < 4; ++j) v[j] = zr[64 * j];
    const GAS float* st = (const GAS float*)(F.STATS + (size_t)m * 16);
    float s1 = 0.f, s2 = 0.f;
#pragma unroll
    for (int k = 0; k < 8; ++k) { s1 += st[2 * k]; s2 += st[2 * k + 1]; }
    const float mean = s1 * (1.f / D); const float var = fmaxf(s2 * (1.f / D) - mean * mean, 0.f);
    const float rstd = 1.f / sqrtf(var + LN_EPS);
#pragma unroll
    for (int j = 0; j < 4; ++j) { const f32x4 gg = *((const GAS f32x4*)F.ln2_g + F.lane + 64 * j), bb = *((const GAS f32x4*)F.ln2_b + F.lane + 64 * j);
        zr[64 * j] = (v[j] - mean) * rstd * gg + bb; }
}

struct Args { const float* in[21]; float* out; unsigned char* ws; int ph_lo, ph_hi, li, pad; };
__global__ void __launch_bounds__(NWAVES * 64, 2) fwd_kernel(Args args) {
    extern __shared__ __attribute__((aligned(16))) unsigned char lds[];
    Frame F;
    F.lds = (LAS unsigned char*)lds;
    F.MISC = (volatile LAS unsigned*)(F.lds + MISC_OFF);
    F.tid = threadIdx.x; F.lane = F.tid & 63; F.wave = __builtin_amdgcn_readfirstlane(F.tid >> 6);
    F.G = gridDim.x; { const int bx = blockIdx.x; F.vcu = (F.G % 8 == 0) ? (bx % 8) * (F.G / 8) + bx / 8 : bx; }
    unsigned char* ws = args.ws;
    F.ctl = (gu32*)(ws + WS_CTL);
    F.x = args.in[0]; F.w_in = args.in[1]; F.b_in = args.in[2]; F.cw_dw = args.in[3]; F.cb_dw = args.in[4]; F.cln_g = args.in[5]; F.cln_b = args.in[6];
    F.w_pw2 = args.in[7]; F.b_pw2 = args.in[8]; F.w_o = args.in[9]; F.w_out = args.in[10]; F.b_out = args.in[11]; F.ln1_g = args.in[12]; F.ln1_b = args.in[13];
    F.w_q = args.in[14]; F.keys1 = args.in[15]; F.keys2 = args.in[16]; F.pu = args.in[17]; F.pv = args.in[18]; F.ln2_g = args.in[19]; F.ln2_b = args.in[20];
    F.out = args.out;
    F.WinT = (bf16*)(ws + WS_WIN); F.WvT = (bf16*)(ws + WS_WV); F.Wpw2T = (bf16*)(ws + WS_WPW2); F.WoT = (bf16*)(ws + WS_WO); F.WoutT = (bf16*)(ws + WS_WOUT); F.WeffT = (bf16*)(ws + WS_WEFF);
    F.UT = ws + WS_UT; F.VTAB = ws + WS_VTAB; F.USC = (float*)(ws + WS_USC); F.VSC = (float*)(ws + WS_VSC); F.XB = (bf16*)(ws + WS_XB); F.Cb = (bf16*)(ws + WS_C); F.AO = (bf16*)(ws + WS_AO);
    F.GLU = (bf16*)(ws + WS_GLU); F.Qb = (bf16*)(ws + WS_Q); F.Kb = (bf16*)(ws + WS_K); F.VT = (bf16*)(ws + WS_VT); F.M2 = (bf16*)(ws + WS_M2); F.Gt = (bf16*)(ws + WS_G);
    F.R = (float*)(ws + WS_R); F.ST = (float*)(ws + WS_ST); F.GATE = (float*)(ws + WS_GATE); F.IDX = (int*)(ws + WS_IDX); F.PD = (float*)(ws + WS_PD); F.STATS = (float*)(ws + WS_STATS);
    for (int u = F.tid; u < (LDS_BYTES - LDSCTL_OFF) / 4; u += NWAVES * 64) ((LAS unsigned*)(F.lds + LDSCTL_OFF))[u] = 0u;
    __syncthreads();
    XcdBarrier bar; bar.bar = (unsigned*)(F.ctl + CW_BAR); bar.x = 0; bar.st = nullptr;
    if (MK_N_LAUNCHES == 1) bar = xcd_barrier_post((unsigned*)(F.ctl + CW_BAR), F.MISC + 8);
#define GRID_BAR() do { if (MK_N_LAUNCHES == 1) xcd_barrier(bar); } while (0)
    const int lo = args.ph_lo, hi = args.ph_hi;
#ifdef ONLY_PHASE
#define IN(k) ((k) == ONLY_PHASE && lo <= (k) && (k) < hi)
#elif defined(DBG_STOP)
#define IN(k) ((k) <= DBG_STOP && lo <= (k) && (k) < hi)
#else
#define IN(k) (lo <= (k) && (k) < hi)
#endif
#define BOTH(k) (IN(k) && IN((k) + 1))
    const int gw = F.vcu * NWAVES + F.wave, NGW = F.G * NWAVES;

    if (IN(0)) { for (int rep = 0; rep <= REP(0); ++rep) p0_prologue(F); if (BOTH(0)) GRID_BAR(); }

    if (IN(1)) {
        for (int rep = 0; rep <= REP(1); ++rep) {
        { pg8::Gemm g{F.XB, F.WinT, T, NIN, D, D, D}; pg8::StaticOrder S; S.init(T, NIN, F.G, (int)blockIdx.x);
          pg8::EpiIn E{F.b_in, F.GLU, F.Qb, F.Kb, F.Gt, QSCALE};
          pg8::gemm_phase<pg8::EpiIn, pg8::StaticOrder, true, true>(F.lds + RING_OFF, g, S, E); }
        { pg8::Gemm g{F.WvT, F.XB, SBDIM, T, D, D, D}; pg8::StaticOrder S; S.init(SBDIM, T, F.G, (int)blockIdx.x);
          pg8::EpiVT E{F.b_in + 2048, F.VT, T};
          __syncthreads();
          pg8::gemm_phase<pg8::EpiVT, pg8::StaticOrder, false, true>(F.lds + RING_OFF, g, S, E); }
        }
        if (BOTH(1)) GRID_BAR();
    }

    if (IN(2)) {
        for (int rep = 0; rep <= REP(2); ++rep) {
        for (int ct = F.vcu; ct < T / 64; ct += F.G) conv_unit(F, ct);
        for (int task = gw; task < BATCH * SBH * (SEQ / 32); task += NGW) attn_task(F, task);
        }
        if (BOTH(2)) GRID_BAR();
    }

    if (IN(3)) {
        for (int rep = 0; rep <= REP(3); ++rep) {
        { pg8::Gemm g{F.Cb, F.Wpw2T, T, D, CONVD, CONVD, CONVD}; pg8::StaticOrder S; S.init(T, D, F.G, (int)blockIdx.x);
          pg8::EpiGate<false> E{F.b_pw2, F.Gt, F.M2, 0};
          pg8::gemm_phase<pg8::EpiGate<false>, pg8::StaticOrder, true, true>(F.lds + RING_OFF, g, S, E); }
        { pg8::Gemm g{F.AO, F.WoT, T, D, SBDIM, SBDIM, SBDIM}; pg8::StaticOrder S; S.init(T, D, F.G, (int)blockIdx.x);
          pg8::EpiGate<true> E{nullptr, F.Gt, F.M2, 1024};
          pg8::gemm_phase<pg8::EpiGate<true>, pg8::StaticOrder, true, true>(F.lds + RING_OFF, g, S, E); }
        }
        if (BOTH(3)) GRID_BAR();
    }

    if (IN(4)) {
        for (int rep = 0; rep <= REP(4); ++rep) {
        pg8::Gemm g{F.M2, F.WoutT, T, D, D, D, D}; pg8::StaticOrder S; S.init(T, D, F.G, (int)blockIdx.x);
        pg8::EpiRes E{F.R, F.x, F.b_out, ALPHA, D};
        pg8::gemm_phase<pg8::EpiRes, pg8::StaticOrder, true, true>(F.lds + RING_OFF, g, S, E);
        }
        if (BOTH(4)) GRID_BAR();
    }

    if (IN(5)) {
        for (int rep = 0; rep <= REP(5); ++rep)
        for (int m = gw; m < T; m += NGW) ln1_row(F, m);
        if (BOTH(5)) GRID_BAR();
    }

    if (IN(6)) {
        for (int rep = 0; rep <= REP(6); ++rep) {
        pg8::Gemm g{F.WeffT, F.XB, 2048, T, D, D, D}; pg8::StaticOrder S; S.init(2048, T, F.G, (int)blockIdx.x);
        pg8::EpiF16 E{(unsigned short*)F.ST, T};
        pg8::gemm_phase<pg8::EpiF16, pg8::StaticOrder, true, true>(F.lds + RING_OFF, g, S, E);
        }
        if (BOTH(6)) GRID_BAR();
    }

    if (IN(7)) {
        for (int rep = 0; rep <= REP(7); ++rep)
        for (int task = gw; task < (T / 64) * PH; task += NGW) select_task(F, task);
        if (BOTH(7)) GRID_BAR();
    }

    if (IN(8)) {
        for (int rep = 0; rep <= REP(8); ++rep) peer_slice_phase<false>(F);
        if (BOTH(8)) GRID_BAR();
    }
    if (IN(9)) {
        peer_coef_phase(F);
        if (BOTH(9)) GRID_BAR();
    }
    if (IN(10)) {
        for (int rep = 0; rep <= REP(10); ++rep) peer_slice_phase<true>(F);
        if (BOTH(10)) GRID_BAR();
    }
    if (IN(11)) {
        for (int rep = 0; rep <= REP(11); ++rep)
        for (int m = gw; m < T; m += NGW) ln2_row(F, m);
    }
#ifdef DBG_STOP
    if (lo <= 11 && 11 < hi) {
        GRID_BAR();
        { const unsigned long long t0 = __builtin_amdgcn_s_memrealtime(); while (__builtin_amdgcn_s_memrealtime() - t0 < 30000ull) __builtin_amdgcn_s_sleep(32); }
        GRID_BAR();
        const size_t n4 = (size_t)T * D / 4;
        for (size_t i = (size_t)gw * 64 + F.lane; i < n4; i += (size_t)NGW * 64) {
            f32x4 v = (f32x4){0.f, 0.f, 0.f, 0.f};
            if (DBG_STOP == 4) { v = ((const GAS f32x4*)F.R)[i]; v = (f32x4){bflo(f2bf(v.x)), bflo(f2bf(v.y)), bflo(f2bf(v.z)), bflo(f2bf(v.w))}; }
            else if (DBG_STOP == 3) { const v2u w = ((const GAS v2u*)F.M2)[i]; const v2u w2 = ((const GAS v2u*)F.M2)[i + n4]; v = (f32x4){bflo(w.x) + bflo(w2.x), bfhi(w.x) + bfhi(w2.x), bflo(w.y) + bflo(w2.y), bfhi(w.y) + bfhi(w2.y)}; }
            else if (DBG_STOP == 2) { const size_t r = i / 256, c4 = i % 256; const bf16* src = (c4 < 128) ? F.Cb + r * 512 + c4 * 4 : F.AO + r * 512 + (c4 - 128) * 4; const v2u w = *(const GAS v2u*)src; v = (f32x4){bflo(w.x), bfhi(w.x), bflo(w.y), bfhi(w.y)}; }
            else if (DBG_STOP == 1) { const v2u w = ((const GAS v2u*)F.Gt)[i]; v = (f32x4){bflo(w.x), bfhi(w.x), bflo(w.y), bfhi(w.y)}; }
            else if (DBG_STOP == 5) { const v2u w = ((const GAS v2u*)F.XB)[i]; v = (f32x4){bflo(w.x), bfhi(w.x), bflo(w.y), bfhi(w.y)}; }
            else if (DBG_STOP == 6) v = ((const GAS f32x4*)F.ST)[i] + ((const GAS f32x4*)F.ST)[i + n4];
            else if (DBG_STOP == 7) { if (i < (size_t)T * 32) { const v4u w = ((const GAS v4u*)F.IDX)[i]; v = (f32x4){(float)w.x, (float)w.y, (float)w.z, (float)w.w}; } else if (i < (size_t)T * 64) v = ((const GAS f32x4*)F.GATE)[i - (size_t)T * 32]; }
            ((GAS f32x4*)F.out)[i] = v; }
    }
#endif
#undef IN
#undef BOTH
}

extern "C" void kernel_launch(void* const* d_in, const int* in_sizes, int n_in, void* d_out, int out_size, void* d_ws, size_t ws_size, hipStream_t stream) {
    static int grid = 0;
    if (grid == 0) {
        if (n_in != 21 || in_sizes[0] != T * D || out_size != T * D || ws_size < WS_END) { fprintf(stderr, "kernel_launch: unexpected shapes (n_in %d, in0 %d, out %d, ws %zu); nothing launched\n", n_in, n_in > 0 ? in_sizes[0] : -1, out_size, ws_size); grid = -1; return; }
        int dev = 0, cus = 0, per_cu = 0;
        if (hipGetDevice(&dev) != hipSuccess || hipDeviceGetAttribute(&cus, hipDeviceAttributeMultiprocessorCount, dev) != hipSuccess) { grid = -1; return; }
        if (hipFuncSetAttribute((const void*)fwd_kernel, hipFuncAttributeMaxDynamicSharedMemorySize, LDS_BYTES) != hipSuccess) { fprintf(stderr, "kernel_launch: hipFuncSetAttribute failed\n"); grid = -1; return; }
        if (hipOccupancyMaxActiveBlocksPerMultiprocessor(&per_cu, (const void*)fwd_kernel, NWAVES * 64, LDS_BYTES) != hipSuccess || per_cu < 1)
            fprintf(stderr, "kernel_launch: note: occupancy query reports %d workgroups per CU\n", per_cu);
        (void)hipGetLastError();
        grid = cus;
    }
    if (grid < 0) return;
    if (hipMemsetAsync((char*)d_ws + WS_CTL, 0, CTL_ZERO_BYTES, stream) != hipSuccess) return;
    Args a{};
    for (int i = 0; i < 21; ++i) a.in[i] = (const float*)d_in[i];
    a.out = (float*)d_out; a.ws = (unsigned char*)d_ws;
    for (int li = 0; li < MK_N_LAUNCHES; ++li) {
        a.ph_lo = (MK_N_LAUNCHES == 1) ? 0 : li; a.ph_hi = (MK_N_LAUNCHES == 1) ? N_PHASES : li + 1; a.li = li;
        hipLaunchKernelGGL(fwd_kernel, dim3(grid), dim3(NWAVES * 64), LDS_BYTES, stream, a);
    }
}
```
